# Optimizing an MI355X kernel written in HIP

```python
import math
import jax, jax.numpy as jnp
from jax import lax
import numpy as np

D_MODEL = 1024
BATCH = 8
SEQ = 2048
DEPTH = 4
DEC_BATCH = 128
DEC_SEQ = 1
PAST_LEN = 16384
PAGE_SIZE = 128

D_CONV = 512
H_M = 4
DH_M = 256
D_M = H_M * DH_M
CONV_W = 3
D_FF = 2816
CHUNK = 128
EPS = 1e-5
ALPHA = (2.0 * DEPTH) ** 0.25
BETA = (8.0 * DEPTH) ** -0.25

SPLITS = (D_CONV, D_CONV, D_CONV, D_M, D_M, D_M, D_M, H_M, H_M, D_MODEL, D_MODEL)
D_IN = sum(SPLITS)
SPLIT_IDX = tuple(int(s) for s in np.cumsum(SPLITS)[:-1])

kernel_name = "hybrid_shortconv_mlstm_convffn_deepnorm_step"


def layer_norm(x, g, b):
    xf = x.astype(jnp.float32)
    mu = jnp.mean(xf, axis=-1, keepdims=True)
    var = jnp.mean(jnp.square(xf - mu), axis=-1, keepdims=True)
    y = (xf - mu) * lax.rsqrt(var + EPS) * g.astype(jnp.float32) + b.astype(jnp.float32)
    return y.astype(x.dtype)


def causal_dwconv(u, buf, w):
    t = u.shape[1]
    full = jnp.concatenate([buf.astype(u.dtype), u], axis=1)
    y = full[:, 0:t] * w[0]
    for j in range(1, CONV_W):
        y = y + full[:, j:j + t] * w[j]
    return y, full[:, -(CONV_W - 1):]


def mlstm_chunked(q, k, v, li, lf, c0, n0, m0):
    bsz, t, h, _ = q.shape
    dv = v.shape[-1]
    L = CHUNK if t % CHUNK == 0 else t
    nc = t // L
    f32 = jnp.float32

    def seq_chunks(a):
        return a.astype(f32).reshape(bsz, nc, L, h, -1).transpose(1, 0, 3, 2, 4)

    def gate_chunks(a):
        return a.reshape(bsz, nc, L, h).transpose(1, 0, 3, 2)

    xs = (seq_chunks(q), seq_chunks(k), seq_chunks(v), gate_chunks(li), gate_chunks(lf))
    causal = jnp.tril(jnp.ones((L, L), dtype=bool))

    def step(carry, inp):
        c, n, m = carry
        qc, kc, vc, lic, lfc = inp
        b = jnp.cumsum(lfc, axis=-1)
        d = b[..., :, None] - b[..., None, :] + lic[..., None, :]
        d = jnp.where(causal, d, -jnp.inf)
        m_inter = b + m[..., None]
        m_t = jnp.maximum(m_inter, jnp.max(d, axis=-1))
        s = jnp.einsum('bhtd,bhsd->bhts', qc, kc) * jnp.exp(d - m_t[..., None])
        scale_inter = jnp.exp(m_inter - m_t)
        numer = (jnp.einsum('bhts,bhsv->bhtv', s, vc)
                 + scale_inter[..., None] * jnp.einsum('bhtk,bhkv->bhtv', qc, c))
        den = jnp.sum(s, axis=-1) + scale_inter * jnp.einsum('bhtk,bhk->bht', qc, n)
        hc = numer / jnp.maximum(jnp.abs(den), jnp.exp(-m_t))[..., None]
        b_last = b[..., -1]
        w = b_last[..., None] - b + lic
        m_new = jnp.maximum(b_last + m, jnp.max(w, axis=-1))
        decay = jnp.exp(b_last + m - m_new)
        w = jnp.exp(w - m_new[..., None])
        c_new = decay[..., None, None] * c + jnp.einsum('bhsk,bhsv->bhkv', kc * w[..., None], vc)
        n_new = decay[..., None] * n + jnp.einsum('bhs,bhsk->bhk', w, kc)
        return (c_new, n_new, m_new), hc

    (c, n, m), hs = lax.scan(step, (c0.astype(f32), n0.astype(f32), m0.astype(f32)), xs)
    h_out = hs.transpose(1, 0, 3, 2, 4).reshape(bsz, t, h, dv)
    return h_out, c, n, m


def trunk_layer(x, sconv_buf, c0, n0, m0, ffn_buf,
                w_in, b_igate, b_fgate, w_conv_mix, mhln_g, w_proj_a, w_proj_b, w_mix_out,
                ln1_g, ln1_b, w_ffn_up, w_ffn_conv, w_ffn_down, ln2_g, ln2_b):
    bsz, t, _ = x.shape
    z = x @ w_in
    bg, cg, xv, q, k, v, og, ig, fg, ga, gb = jnp.split(z, SPLIT_IDX, axis=-1)

    conv_out, sconv_new = causal_dwconv(cg * xv, sconv_buf, w_conv_mix)
    ya = (bg * conv_out) @ w_proj_a

    q = q.reshape(bsz, t, H_M, DH_M)
    k = k.reshape(bsz, t, H_M, DH_M) * (DH_M ** -0.5)
    v = v.reshape(bsz, t, H_M, DH_M)
    li = (ig + b_igate).astype(jnp.float32)
    lf = jax.nn.log_sigmoid((fg + b_fgate).astype(jnp.float32))
    hm, c_new, n_new, m_new = mlstm_chunked(q, k, v, li, lf, c0, n0, m0)
    mu = jnp.mean(hm, axis=-1, keepdims=True)
    var = jnp.mean(jnp.square(hm - mu), axis=-1, keepdims=True)
    hm = ((hm - mu) * lax.rsqrt(var + EPS)).reshape(bsz, t, D_M) * mhln_g.astype(jnp.float32)
    hm = jax.nn.sigmoid(og) * hm.astype(x.dtype)
    yb = hm @ w_proj_b

    merged = jax.nn.sigmoid(ga) * ya + jax.nn.sigmoid(gb) * yb
    x = layer_norm(ALPHA * x + merged @ w_mix_out, ln1_g, ln1_b)

    up = x @ w_ffn_up
    up_c, ffn_new = causal_dwconv(up, ffn_buf, w_ffn_conv)
    g, u = jnp.split(up_c, 2, axis=-1)
    x = layer_norm(ALPHA * x + (jax.nn.silu(g) * u) @ w_ffn_down, ln2_g, ln2_b)

    return (x, sconv_new, c_new.astype(c0.dtype), n_new.astype(n0.dtype),
            m_new.astype(m0.dtype), ffn_new)


def setup_inputs(seed: int = 0) -> dict:
    key = jax.random.key(seed)
    ks = jax.random.split(key, 32)
    nrm = jax.random.normal
    f32 = jnp.float32
    x_prompt = nrm(ks[0], (BATCH, SEQ, D_MODEL), f32)
    x_sample = nrm(ks[1], (DEC_BATCH, DEC_SEQ, D_MODEL), f32)
    cache_sconv = 0.5 * nrm(ks[2], (DEPTH, DEC_BATCH, CONV_W - 1, D_CONV), f32)
    state_mlstm_C = 0.1 * nrm(ks[3], (DEPTH, DEC_BATCH, H_M, DH_M, DH_M), f32)
    state_mlstm_n = 0.1 * nrm(ks[4], (DEPTH, DEC_BATCH, H_M, DH_M), f32)
    state_mlstm_m = jax.random.uniform(ks[5], (DEPTH, DEC_BATCH, H_M), f32, 0.0, 5.0)
    cache_ffn_conv = nrm(ks[6], (DEPTH, DEC_BATCH, CONV_W - 1, 2 * D_FF), f32)

    w_in = nrm(ks[7], (DEPTH, D_MODEL, D_IN), f32) * D_MODEL ** -0.5
    b_igate = 0.1 * nrm(ks[8], (DEPTH, H_M), f32)
    b_fgate = jnp.linspace(3.0, 6.0, H_M, dtype=f32)[None, :] + 0.1 * nrm(ks[9], (DEPTH, H_M), f32)
    w_conv_mix = 0.5 * nrm(ks[10], (DEPTH, CONV_W, D_CONV), f32)
    mhln_g = 1.0 + 0.1 * nrm(ks[11], (DEPTH, D_M), f32)
    w_proj_a = nrm(ks[12], (DEPTH, D_CONV, D_MODEL), f32) * D_CONV ** -0.5
    w_proj_b = nrm(ks[13], (DEPTH, D_M, D_MODEL), f32) * D_M ** -0.5
    w_mix_out = nrm(ks[14], (DEPTH, D_MODEL, D_MODEL), f32) * (D_MODEL ** -0.5) * BETA
    ln1_g = 1.0 + 0.05 * nrm(ks[15], (DEPTH, D_MODEL), f32)
    ln1_b = 0.02 * nrm(ks[16], (DEPTH, D_MODEL), f32)
    w_ffn_up = nrm(ks[17], (DEPTH, D_MODEL, 2 * D_FF), f32) * D_MODEL ** -0.5
    w_ffn_conv = 0.5 * nrm(ks[18], (DEPTH, CONV_W, 2 * D_FF), f32)
    w_ffn_down = nrm(ks[19], (DEPTH, D_FF, D_MODEL), f32) * (D_FF ** -0.5) * BETA
    ln2_g = 1.0 + 0.05 * nrm(ks[20], (DEPTH, D_MODEL), f32)
    ln2_b = 0.02 * nrm(ks[21], (DEPTH, D_MODEL), f32)
    return {
        "x_prompt": x_prompt, "x_sample": x_sample,
        "cache_sconv": cache_sconv, "state_mlstm_C": state_mlstm_C,
        "state_mlstm_n": state_mlstm_n, "state_mlstm_m": state_mlstm_m,
        "cache_ffn_conv": cache_ffn_conv,
        "w_in": w_in, "b_igate": b_igate, "b_fgate": b_fgate, "w_conv_mix": w_conv_mix,
        "mhln_g": mhln_g, "w_proj_a": w_proj_a, "w_proj_b": w_proj_b, "w_mix_out": w_mix_out,
        "ln1_g": ln1_g, "ln1_b": ln1_b, "w_ffn_up": w_ffn_up, "w_ffn_conv": w_ffn_conv,
        "w_ffn_down": w_ffn_down, "ln2_g": ln2_g, "ln2_b": ln2_b,
    }


def reference(x_prompt, x_sample, cache_sconv, state_mlstm_C, state_mlstm_n, state_mlstm_m,
              cache_ffn_conv, w_in, b_igate, b_fgate, w_conv_mix, mhln_g, w_proj_a, w_proj_b,
              w_mix_out, ln1_g, ln1_b, w_ffn_up, w_ffn_conv, w_ffn_down, ln2_g, ln2_b):
    dt = x_prompt.dtype
    bsz = x_prompt.shape[0]
    zero_sconv = jnp.zeros((bsz, CONV_W - 1, D_CONV), dt)
    zero_c = jnp.zeros((bsz, H_M, DH_M, DH_M), dt)
    zero_n = jnp.zeros((bsz, H_M, DH_M), dt)
    zero_m = jnp.zeros((bsz, H_M), dt)
    zero_ffn = jnp.zeros((bsz, CONV_W - 1, 2 * D_FF), dt)

    xp, xs = x_prompt, x_sample
    sp_l, ss_l, cp_l, cs_l, np_l, ns_l, mp_l, ms_l, fp_l, fs_l = ([] for _ in range(10))
    for l in range(DEPTH):
        params = (w_in[l], b_igate[l], b_fgate[l], w_conv_mix[l], mhln_g[l], w_proj_a[l],
                  w_proj_b[l], w_mix_out[l], ln1_g[l], ln1_b[l], w_ffn_up[l], w_ffn_conv[l],
                  w_ffn_down[l], ln2_g[l], ln2_b[l])
        xp, sp, cp, np_, mp, fp = trunk_layer(xp, zero_sconv, zero_c, zero_n, zero_m, zero_ffn, *params)
        xs, ss, cs, ns, ms, fs = trunk_layer(xs, cache_sconv[l], state_mlstm_C[l], state_mlstm_n[l],
                                             state_mlstm_m[l], cache_ffn_conv[l], *params)
        sp_l.append(sp); ss_l.append(ss); cp_l.append(cp); cs_l.append(cs)
        np_l.append(np_); ns_l.append(ns); mp_l.append(mp); ms_l.append(ms)
        fp_l.append(fp); fs_l.append(fs)

    return (xp, xs,
            jnp.stack(sp_l), jnp.stack(ss_l),
            jnp.stack(cp_l), jnp.stack(cs_l),
            jnp.stack(np_l), jnp.stack(ns_l),
            jnp.stack(mp_l), jnp.stack(ms_l),
            jnp.stack(fp_l), jnp.stack(fs_l))
```

```cpp
#include <hip/hip_runtime.h>
#include <hip/hip_cooperative_groups.h>
#include <cstdio>
namespace cg = cooperative_groups;
#include <hip/hip_runtime.h>
namespace pg8 {
#define PG8_LAS __attribute__((address_space(3)))
typedef unsigned short bf16_t;
typedef short bf16x8 __attribute__((ext_vector_type(8)));
typedef float f32x4 __attribute__((ext_vector_type(4)));
typedef unsigned u32x4 __attribute__((ext_vector_type(4)));
constexpr int BM = 256, BK = 64, HALF = 128, HTB = HALF * BK * 2  , STAGE_BYTES = 8 * HTB, NXCD = 8, WGM = 8;

__host__ __device__ __forceinline__ int lds_byte(int r, int c) { const int st = (r >> 4) * 2 + (c >> 5), rr = r & 15, cc = c & 31, ob = rr * 64 + cc * 2; return st * 1024 + (ob ^ (((ob >> 9) & 1) << 5)); }
__host__ __device__ __forceinline__ void stage_rc(int b, int& R, int& C) { const int st = b / 1024, sb = b % 1024, swz = sb ^ (((sb >> 9) & 1) << 5); R = (st >> 1) * 16 + swz / 64; C = (st & 1) * 32 + (swz % 64) / 2; }
__host__ __device__ __forceinline__ int perm32(int rho) { const int n = rho >> 4, i = rho & 15; return 8 * (i >> 2) + 4 * n + (i & 3); }

struct Unit { int pm, pn; };
struct Gemm { const bf16_t* A; const bf16_t* Bt; int M, N, K; };

struct StaticOrder {
    int nM, nN, nwg, G, c;
    __host__ __device__ void init(int M, int N, int G_, int c_) { nM = M / BM; nN = N / BM; nwg = nM * nN; G = G_; c = c_; }
    __host__ __device__ bool next(int i, Unit& u) const {
        const long L = (long)i * G + c; if (L >= nwg) return false;
        int wgid = (int)L; { const int q = nwg / NXCD, r = nwg % NXCD, xcd = wgid % NXCD, off = wgid / NXCD; wgid = (xcd < r ? xcd * (q + 1) : r * (q + 1) + (xcd - r) * q) + off; }
        const int nig = WGM * nN, gid = wgid / nig, fm = gid * WGM, gsz = (nM - fm) < WGM ? (nM - fm) : WGM;
        u.pm = fm + ((wgid % nig) % gsz); u.pn = (wgid % nig) / gsz; return true;
    }
    __device__ __forceinline__ void a_ready(const Unit&) const {}
    __device__ __forceinline__ void done(const Unit&) const {}
};
__device__ __forceinline__ unsigned cvt_pk_bf16(float lo, float hi) { unsigned r; asm volatile("v_cvt_pk_bf16_f32 %0, %1, %2" : "=v"(r) : "v"(lo), "v"(hi)); return r; }
typedef float f32x2 __attribute__((ext_vector_type(2)));
__device__ __forceinline__ f32x2 gelu_pk(f32x2 v) {
    const f32x2 av = __builtin_elementwise_abs(v), d = av * 0.2316418882f + 1.0f;
    f32x2 t; t.x = __builtin_amdgcn_rcpf(d.x); t.y = __builtin_amdgcn_rcpf(d.y);
    f32x2 q = t * 0.5307027145f + (-0.7265760135f); q = q * t + 0.7107068705f; q = q * t + (-0.142248368f); q = q * t + 0.127414796f; q = q * t;
    const f32x2 s = (v * v) * (-0.72134752044f);
    f32x2 e; e.x = __builtin_amdgcn_exp2f(s.x); e.y = __builtin_amdgcn_exp2f(s.y);
    const f32x2 m = v * (q * e), r = v - m;
    f32x2 o; o.x = v.x < 0.f ? m.x : r.x; o.y = v.y < 0.f ? m.y : r.y; return o;
}

struct EpiF32 {
    static constexpr bool PERM = false, AFTER_DRAIN = false; static constexpr int MID_T = 0;
    float* C; int ldc; const float* bias;
    __device__ __forceinline__ void operator()(const f32x4 (&acc)[2][2][4][2], const Unit& u, int wr, int wc, int fr, int fq) const {
        const int row0 = u.pm * BM + wr * 64 + fr, col0 = u.pn * BM + wc * 32 + 4 * fq;
        f32x4 bv[2][2];
#pragma unroll
        for (int bj = 0; bj < 2; ++bj)
#pragma unroll
            for (int n = 0; n < 2; ++n) bv[bj][n] = bias ? *(const f32x4*)(bias + col0 + bj * HALF + n * 16) : (f32x4){0.f, 0.f, 0.f, 0.f};
#pragma unroll
        for (int ai = 0; ai < 2; ++ai)
#pragma unroll
            for (int m = 0; m < 4; ++m) { float* rowp = C + (size_t)(row0 + ai * HALF + m * 16) * ldc + col0;
#pragma unroll
                for (int bj = 0; bj < 2; ++bj)
#pragma unroll
                    for (int n = 0; n < 2; ++n) *(f32x4*)(rowp + bj * HALF + n * 16) = acc[ai][bj][m][n] + bv[bj][n]; }
    }
};
template <int ACT  > struct EpiBf16 {
    static constexpr bool PERM = true, AFTER_DRAIN = false; static constexpr int MID_T = 0;
    bf16_t* O; int ldc; const float* bias; int split_cols; size_t split_stride;
    __device__ __forceinline__ void operator()(const f32x4 (&acc)[2][2][4][2], const Unit& u, int wr, int wc, int fr, int fq) const {
        const int row0 = u.pm * BM + wr * 64 + fr; int colt = u.pn * BM; bf16_t* base = O;
        if (split_cols) { const int t = colt / split_cols; base += (size_t)t * split_stride; colt -= t * split_cols; }
        const int col0 = colt + wc * 32 + 8 * fq, bcol0 = u.pn * BM + wc * 32 + 8 * fq;
        f32x4 bv[2][2];
#pragma unroll
        for (int bj = 0; bj < 2; ++bj)
#pragma unroll
            for (int n = 0; n < 2; ++n) bv[bj][n] = bias ? *(const f32x4*)(bias + bcol0 + bj * HALF + 4 * n) : (f32x4){0.f, 0.f, 0.f, 0.f};
#pragma unroll
        for (int ai = 0; ai < 2; ++ai)
#pragma unroll
            for (int m = 0; m < 4; ++m) { bf16_t* rowp = base + (size_t)(row0 + ai * HALF + m * 16) * ldc + col0;
#pragma unroll
                for (int bj = 0; bj < 2; ++bj) { f32x4 v0 = acc[ai][bj][m][0] + bv[bj][0], v1 = acc[ai][bj][m][1] + bv[bj][1];
                    if (ACT == 1) { f32x2 a = gelu_pk((f32x2){v0[0], v0[1]}), b = gelu_pk((f32x2){v0[2], v0[3]}), c = gelu_pk((f32x2){v1[0], v1[1]}), d = gelu_pk((f32x2){v1[2], v1[3]});
                        v0 = (f32x4){a.x, a.y, b.x, b.y}; v1 = (f32x4){c.x, c.y, d.x, d.y}; }
                    if (ACT == 2) {
#pragma unroll
                        for (int j = 0; j < 4; ++j) { v0[j] = 0.5f * v0[j] * (1.0f + erff(v0[j] * 0.70710678f)); v1[j] = 0.5f * v1[j] * (1.0f + erff(v1[j] * 0.70710678f)); } }
                    u32x4 w; w.x = cvt_pk_bf16(v0[0], v0[1]); w.y = cvt_pk_bf16(v0[2], v0[3]); w.z = cvt_pk_bf16(v1[0], v1[1]); w.w = cvt_pk_bf16(v1[2], v1[3]);
                    *(u32x4*)(rowp + bj * HALF) = w; } }
    }
};
template <class Epi, class Sched, bool STAMP = false>
__device__ __forceinline__ void gemm_phase(PG8_LAS unsigned char* lds, const Gemm g, const Sched& S, const Epi& E, unsigned long long* stamps) {
    int tid_ = threadIdx.x; asm volatile("" : "+v"(tid_)); const int tid = tid_, wid = __builtin_amdgcn_readfirstlane(tid >> 6), lane = tid & 63, wr = wid >> 2, wc = wid & 3, fr = lane & 15, fq = lane >> 4;
    const int K = g.K, nt = K / BK;
    int ts_lo = 0, ts_hi = 0, nts = 0; const unsigned long long rt_entry = STAMP ? (unsigned long long)wall_clock64() : 0ull;
#define PG8_STAMP() do { if (STAMP && wid == 0 && nts < 64) { const unsigned long long _c = (unsigned long long)clock64(); \
        ts_lo = (lane == nts) ? (int)(unsigned)_c : ts_lo; ts_hi = (lane == nts) ? (int)(unsigned)(_c >> 32) : ts_hi; ++nts; } } while (0)
    PG8_STAMP();
    unsigned voffA[2], voffB[2];
#pragma unroll
    for (int i = 0; i < 2; ++i) { int R, C; stage_rc(tid * 16 + i * 8192, R, C); const int Rb = Epi::PERM ? ((R & ~31) + perm32(R & 31)) : R;
        voffA[i] = (unsigned)(R * K + C) * 2u; voffB[i] = (unsigned)(Rb * K + C) * 2u; }
    const size_t kstep = (size_t)(BK * 2);
    const size_t hstep = (size_t)HALF * K * 2;
    const size_t tstep = 2 * hstep;
    const unsigned ldsw = (unsigned)wid * 1024u;
    const int aoff = lds_byte(wr * 64 + fr, fq * 8), boff = lds_byte(wc * 32 + fr, fq * 8);
#define PG8_SA(b, h) (((b) * 2 + (h)) * HTB)
#define PG8_SB(b, h) ((4 + (b) * 2 + (h)) * HTB)
#define PG8_STAGE(bufoff, gbase, voff) do { _Pragma("unroll") for (int _i = 0; _i < 2; ++_i) \
        __builtin_amdgcn_global_load_lds((const unsigned*)((const char*)(gbase) + (voff)[_i]), (PG8_LAS unsigned*)(lds + (bufoff) + ldsw + _i * 8192), 16, 0, 0); } while (0)
#define PG8_LDA(dst, b, h) do { _Pragma("unroll") for (int m = 0; m < 4; ++m) _Pragma("unroll") for (int k = 0; k < 2; ++k) dst[m][k] = *(const PG8_LAS bf16x8*)(lds + PG8_SA(b, h) + aoff + m * 2048 + k * 1024); } while (0)
#define PG8_LDB(dst, b, h) do { _Pragma("unroll") for (int n = 0; n < 2; ++n) _Pragma("unroll") for (int k = 0; k < 2; ++k) dst[n][k] = *(const PG8_LAS bf16x8*)(lds + PG8_SB(b, h) + boff + n * 2048 + k * 1024); } while (0)
#define PG8_MMA(ai, bj, At, Bt) do { __builtin_amdgcn_s_setprio(1); _Pragma("unroll") for (int m = 0; m < 4; ++m) _Pragma("unroll") for (int n = 0; n < 2; ++n) _Pragma("unroll") for (int k = 0; k < 2; ++k) \
        acc[ai][bj][m][n] = __builtin_amdgcn_mfma_f32_16x16x32_bf16(Bt[n][k], At[m][k], acc[ai][bj][m][n], 0, 0, 0); __builtin_amdgcn_s_setprio(0); } while (0)
#define PG8_WAIT_V(n) asm volatile("s_waitcnt vmcnt(" #n ")" ::: "memory")
#define PG8_WAIT_L(n) asm volatile("s_waitcnt lgkmcnt(" #n ")" ::: "memory")
#define PG8_BAR __builtin_amdgcn_s_barrier()
#define PG8_SCHED __builtin_amdgcn_sched_barrier(0)
    Unit cur, nxt; int ui = 0;
    if (!S.next(0, cur)) return;
    f32x4 acc[2][2][4][2];
#pragma unroll
    for (int a = 0; a < 2; ++a)
#pragma unroll
        for (int b = 0; b < 2; ++b)
#pragma unroll
            for (int m = 0; m < 4; ++m)
#pragma unroll
                for (int n = 0; n < 2; ++n) acc[a][b][m][n] = (f32x4){0.f, 0.f, 0.f, 0.f};
    bf16x8 At[4][2], B0[2][2], B1[2][2];
    const char* cA = (const char*)g.A + (size_t)cur.pm * tstep; const char* cB = (const char*)g.Bt + (size_t)cur.pn * tstep;
    S.a_ready(cur);
    PG8_STAGE(PG8_SB(0, 0), cB, voffB); PG8_STAGE(PG8_SA(0, 0), cA, voffA); PG8_STAGE(PG8_SB(0, 1), cB + hstep, voffB); PG8_STAGE(PG8_SA(0, 1), cA + hstep, voffA);
    if (wr == 1) PG8_BAR;
    PG8_WAIT_V(4); PG8_BAR;
    PG8_STAGE(PG8_SB(1, 0), cB + kstep, voffB); PG8_STAGE(PG8_SA(1, 0), cA + kstep, voffA); PG8_STAGE(PG8_SB(1, 1), cB + hstep + kstep, voffB);
    PG8_WAIT_V(6); PG8_BAR;
    PG8_STAMP();
    for (;;) {
        const bool has_next = S.next(ui + 1, nxt);
        const char* nA = has_next ? (const char*)g.A + (size_t)nxt.pm * tstep : cA; const char* nB = has_next ? (const char*)g.Bt + (size_t)nxt.pn * tstep : cB;
        for (int t = 0; t < nt; t += 2) {
            if constexpr (Epi::MID_T > 0) { if (t == Epi::MID_T) E.mid(acc, cur, wr, wc, fr, fq); }
            const bool last = (t == nt - 2);
            const char* a1 = cA + (size_t)(t + 1) * kstep;
            const char* a2 = last ? nA : cA + (size_t)(t + 2) * kstep; const char* b2 = last ? nB : cB + (size_t)(t + 2) * kstep;
            const char* a3 = a2 + kstep; const char* b3 = b2 + kstep;
            if (last && has_next) S.a_ready(nxt);
            PG8_LDB(B0, 0, 0); PG8_SCHED; PG8_LDA(At, 0, 0); PG8_STAGE(PG8_SA(1, 1), a1 + hstep, voffA);
            PG8_WAIT_L(8); PG8_BAR; PG8_WAIT_L(0); PG8_MMA(0, 0, At, B0); PG8_BAR; PG8_SCHED;
            PG8_LDB(B1, 0, 1); PG8_STAGE(PG8_SB(0, 0), b2, voffB);
            PG8_BAR; PG8_WAIT_L(0); PG8_MMA(0, 1, At, B1); PG8_BAR;
            PG8_LDA(At, 0, 1); PG8_STAGE(PG8_SA(0, 0), a2, voffA);
            PG8_BAR; PG8_WAIT_L(0); PG8_MMA(1, 0, At, B0); PG8_BAR; PG8_SCHED;
            PG8_STAGE(PG8_SB(0, 1), b2 + hstep, voffB);
            PG8_WAIT_V(6); PG8_BAR; PG8_MMA(1, 1, At, B1); PG8_BAR;
            PG8_LDB(B0, 1, 0); PG8_SCHED; PG8_LDA(At, 1, 0); PG8_STAGE(PG8_SA(0, 1), a2 + hstep, voffA);
            PG8_WAIT_L(8); PG8_BAR; PG8_WAIT_L(0); PG8_MMA(0, 0, At, B0); PG8_BAR; PG8_SCHED;
            PG8_LDB(B1, 1, 1); PG8_STAGE(PG8_SB(1, 0), b3, voffB);
            PG8_BAR; PG8_WAIT_L(0); PG8_MMA(0, 1, At, B1); PG8_BAR;
            PG8_LDA(At, 1, 1); PG8_STAGE(PG8_SA(1, 0), a3, voffA);
            PG8_BAR; PG8_WAIT_L(0); PG8_MMA(1, 0, At, B0); PG8_BAR; PG8_SCHED;
            PG8_STAGE(PG8_SB(1, 1), b3 + hstep, voffB);
            PG8_WAIT_V(6); PG8_BAR; PG8_MMA(1, 1, At, B1); PG8_BAR;
        }
        PG8_STAMP();
        if constexpr (!Epi::AFTER_DRAIN) { E(acc, cur, wr, wc, fr, fq); S.done(cur); }
        PG8_STAMP();
        if (!has_next) break;
#pragma unroll
        for (int a = 0; a < 2; ++a)
#pragma unroll
            for (int b = 0; b < 2; ++b)
#pragma unroll
                for (int m = 0; m < 4; ++m)
#pragma unroll
                    for (int n = 0; n < 2; ++n) acc[a][b][m][n] = (f32x4){0.f, 0.f, 0.f, 0.f};
        cur = nxt; cA = nA; cB = nB; ++ui;
    }
    PG8_WAIT_V(0);
    if (wr == 0) PG8_BAR;
    PG8_BAR;
    if constexpr (Epi::AFTER_DRAIN) { E.fused(acc, cur, wr, wc, fr, fq, lds, wid, lane); S.done(cur); }
    PG8_STAMP();
    if (STAMP && wid == 0) { stamps[lane] = lane < nts ? (((unsigned long long)(unsigned)ts_hi << 32) | (unsigned)ts_lo) : 0ull;
        if (lane == 62) stamps[62] = rt_entry; if (lane == 63) stamps[63] = (unsigned long long)wall_clock64(); }
#undef PG8_STAMP
#undef PG8_SA
#undef PG8_SB
#undef PG8_STAGE
#undef PG8_LDA
#undef PG8_LDB
#undef PG8_MMA
#undef PG8_WAIT_V
#undef PG8_WAIT_L
#undef PG8_BAR
#undef PG8_SCHED
}
}

#define LAS __attribute__((address_space(3)))
using pg8::bf16_t; using pg8::bf16x8; using pg8::f32x4;
typedef unsigned u32x2 __attribute__((ext_vector_type(2)));
typedef unsigned u32x4v __attribute__((ext_vector_type(4)));
typedef short s16x4 __attribute__((ext_vector_type(4)));

constexpr int DM = 1024, SEQ = 2048, NBATCH = 8, TP = NBATCH * SEQ, NSMP = 128, MT = TP + NSMP, MP = 16640;
constexpr int DEPTH = 4, DCONV = 512, HM = 4, DH = 256, DFF = 2816, DIN = 7688, ZN = 7680, DUP = 2 * DFF, KPR = 1536;
constexpr float LN_EPS = 1e-5f;
constexpr float ALPHA = 1.681792830507429f;
constexpr int ZC_BG = 0, ZC_CG = 512, ZC_XV = 1024, ZC_Q = 1536, ZC_K = 2560, ZC_V = 3584, ZC_O = 4608, ZC_GA = 5632, ZC_GB = 6656;
constexpr long O_YP = 0, O_YS = 16777216, O_SCP = 16908288, O_SCS = 16941056, O_CP = 17465344, O_CS = 25853952, O_NP = 160071680, O_NS = 160104448,
               O_MP = 160628736, O_MS = 160628864, O_FP = 160630912, O_FS = 160991360;
constexpr size_t al256(size_t x) { return (x + 255) & ~(size_t)255; }
constexpr size_t WS_WIN = 0;
constexpr size_t WS_WPR = al256(WS_WIN + (size_t)DEPTH * ZN * DM * 2);
constexpr size_t WS_WMX = al256(WS_WPR + (size_t)DEPTH * DM * KPR * 2);
constexpr size_t WS_WUP = al256(WS_WMX + (size_t)DEPTH * DM * DM * 2);
constexpr size_t WS_WDN = al256(WS_WUP + (size_t)DEPTH * DUP * DM * 2);
constexpr size_t WS_XF = al256(WS_WDN + (size_t)DEPTH * DM * DFF * 2);
constexpr size_t WS_XB = al256(WS_XF + (size_t)MP * DM * 4);
constexpr size_t WS_HB = al256(WS_XB + (size_t)MP * DM * 2);
constexpr size_t WS_ZB = al256(WS_HB + (size_t)MP * DM * 4);
constexpr size_t WS_GT = al256(WS_ZB + (size_t)MP * ZN * 2);
constexpr size_t WS_GTAB = al256(WS_GT + (size_t)MP * 8 * 4);
constexpr size_t WS_AB = al256(WS_GTAB + (size_t)TP * 16 * 4);
constexpr size_t WS_MG = al256(WS_AB + (size_t)MP * KPR * 2);
constexpr size_t WS_UP = al256(WS_MG + (size_t)MP * DM * 2);
constexpr size_t WS_ACT = al256(WS_UP + (size_t)MP * DUP * 2);
constexpr size_t WS_CST = al256(WS_ACT + (size_t)MP * DFF * 2);
constexpr size_t WS_NST = al256(WS_CST + (size_t)32 * 16 * 256 * 256 * 2);
constexpr size_t WS_END = al256(WS_NST + (size_t)32 * 16 * 256 * 4);
constexpr int LDS_BYTES = 147456;

struct Params {
    const float* in[22];
    float* out;
    unsigned char* ws;
    int ph_lo, ph_hi;
};
typedef const __attribute__((address_space(4))) Params* KP;

__device__ __forceinline__ float bf2f(unsigned short b) { return __uint_as_float(((unsigned)b) << 16); }
__device__ __forceinline__ float bflo(unsigned w) { return __uint_as_float(w << 16); }
__device__ __forceinline__ float bfhi(unsigned w) { return __uint_as_float(w & 0xffff0000u); }
__device__ __forceinline__ unsigned pk2(float lo, float hi) { return pg8::cvt_pk_bf16(lo, hi); }
__device__ __forceinline__ unsigned short f2bf(float x) { return (unsigned short)(pg8::cvt_pk_bf16(x, 0.f) & 0xffffu); }
__device__ __forceinline__ float sigmoidf_(float x) { return __builtin_amdgcn_rcpf(1.0f + __expf(-x)); }
__device__ __forceinline__ float logsigmoidf_(float x) { return (x >= 0.f) ? -log1pf(expf(-x)) : (x - log1pf(expf(x))); }
__device__ __forceinline__ float wsum(float v) {
#pragma unroll
    for (int o = 32; o >= 1; o >>= 1) v += __shfl_xor(v, o);
    return v;
}
__device__ __forceinline__ void bar() { __syncthreads(); }
__device__ __forceinline__ s16x4 tr_read(const LAS unsigned char* p) {
    return __builtin_bit_cast(s16x4, __builtin_amdgcn_ds_read_tr16_b64_v4i16((LAS s16x4*)p));
}
__device__ __forceinline__ bf16x8 cat8(s16x4 a, s16x4 b) { bf16x8 r; r[0] = a[0]; r[1] = a[1]; r[2] = a[2]; r[3] = a[3]; r[4] = b[0]; r[5] = b[1]; r[6] = b[2]; r[7] = b[3]; return r; }
__device__ __forceinline__ f32x4 mfma16(bf16x8 a, bf16x8 b, f32x4 c) { return __builtin_amdgcn_mfma_f32_16x16x32_bf16(a, b, c, 0, 0, 0); }

__device__ void prep_weights(KP P, LAS unsigned char* lds) {
    LAS float* T = (LAS float*)lds;
    constexpr int T_IN = 16 * 120, T_PA = 8 * 16, T_PB = 16 * 16, T_MX = 16 * 16, T_UP = 16 * 88, T_DN = 44 * 16;
    constexpr int T_L = T_IN + T_PA + T_PB + T_MX + T_UP + T_DN;
    int tid_ = threadIdx.x; asm volatile("" : "+v"(tid_)); const int tid = tid_;
    for (int it = blockIdx.x; it < DEPTH * T_L; it += gridDim.x) {
        const int l = it / T_L; int r = it % T_L;
        const float* src; bf16_t* dst; int ldsrc, lddst, k0, srcn0, dn0, dk0; float scale = 1.0f;
        if (r < T_IN) {
            const int kt = r & 15, nt = r >> 4; k0 = kt * 64; dn0 = nt * 64; srcn0 = dn0 < 5632 ? dn0 : dn0 + 8; dk0 = k0;
            src = P->in[7] + (size_t)l * DM * DIN; ldsrc = DIN; dst = (bf16_t*)(P->ws + WS_WIN) + (size_t)l * ZN * DM; lddst = DM;
            if (dn0 >= ZC_K && dn0 < ZC_V) scale = 0.0625f;
        } else if ((r -= T_IN) < T_PA) {
            const int kt = r & 7, nt = r >> 3; k0 = kt * 64; dn0 = nt * 64; srcn0 = dn0; dk0 = k0;
            src = P->in[12] + (size_t)l * DCONV * DM; ldsrc = DM; dst = (bf16_t*)(P->ws + WS_WPR) + (size_t)l * DM * KPR; lddst = KPR;
        } else if ((r -= T_PA) < T_PB) {
            const int kt = r & 15, nt = r >> 4; k0 = kt * 64; dn0 = nt * 64; srcn0 = dn0; dk0 = 512 + k0;
            src = P->in[13] + (size_t)l * DM * DM; ldsrc = DM; dst = (bf16_t*)(P->ws + WS_WPR) + (size_t)l * DM * KPR; lddst = KPR;
        } else if ((r -= T_PB) < T_MX) {
            const int kt = r & 15, nt = r >> 4; k0 = kt * 64; dn0 = nt * 64; srcn0 = dn0; dk0 = k0;
            src = P->in[14] + (size_t)l * DM * DM; ldsrc = DM; dst = (bf16_t*)(P->ws + WS_WMX) + (size_t)l * DM * DM; lddst = DM;
        } else if ((r -= T_MX) < T_UP) {
            const int kt = r & 15, nt = r >> 4; k0 = kt * 64; dn0 = nt * 64; srcn0 = dn0; dk0 = k0;
            src = P->in[17] + (size_t)l * DM * DUP; ldsrc = DUP; dst = (bf16_t*)(P->ws + WS_WUP) + (size_t)l * DUP * DM; lddst = DM;
        } else {
            r -= T_UP;
            const int kt = r % 44, nt = r / 44; k0 = kt * 64; dn0 = nt * 64; srcn0 = dn0; dk0 = k0;
            src = P->in[19] + (size_t)l * DFF * DM; ldsrc = DM; dst = (bf16_t*)(P->ws + WS_WDN) + (size_t)l * DM * DFF; lddst = DFF;
        }
#pragma unroll
        for (int i = 0; i < 2; ++i) {
            const int idx = tid + i * 512, kk = idx >> 4, nv = idx & 15;
            const float4 v = *(const float4*)(src + (size_t)(k0 + kk) * ldsrc + srcn0 + nv * 4);
            T[(nv * 4 + 0) * 65 + kk] = v.x; T[(nv * 4 + 1) * 65 + kk] = v.y; T[(nv * 4 + 2) * 65 + kk] = v.z; T[(nv * 4 + 3) * 65 + kk] = v.w;
        }
        bar();
        {
            const int nn = tid >> 3, kc = tid & 7;
            const LAS float* t = T + nn * 65 + kc * 8;
            u32x4v w;
            w.x = pk2(t[0] * scale, t[1] * scale); w.y = pk2(t[2] * scale, t[3] * scale); w.z = pk2(t[4] * scale, t[5] * scale); w.w = pk2(t[6] * scale, t[7] * scale);
            *(u32x4v*)(dst + (size_t)(dn0 + nn) * lddst + dk0 + kc * 8) = w;
        }
        bar();
    }
}

template <int MODE>
__device__ void row_phase(KP P, int l, LAS unsigned char* lds) {
    int tid_ = threadIdx.x; asm volatile("" : "+v"(tid_)); const int tid = tid_, wid = __builtin_amdgcn_readfirstlane(tid >> 6), lane = tid & 63;
    constexpr bool LN = MODE != 0, GATES = (MODE == 0 || MODE == 2);
    LAS float* Wg = (LAS float*)lds;
    float* xf = (float*)(P->ws + WS_XF); bf16_t* xb = (bf16_t*)(P->ws + WS_XB); const float* hb = (const float*)(P->ws + WS_HB); float* gt = (float*)(P->ws + WS_GT);
    if (GATES) {
        const int gl = (MODE == 0) ? 0 : l + 1;
        const float* w = P->in[7] + (size_t)gl * DM * DIN + 5632;
        for (int idx = tid; idx < 8192; idx += 512) Wg[idx] = w[(size_t)(idx >> 3) * DIN + (idx & 7)];
        bar();
    }
    if (MODE == 0) {
        for (int idx = blockIdx.x * 512 + tid; idx < (MP - MT) * DM / 8; idx += gridDim.x * 512) *(u32x4v*)(xb + (size_t)MT * DM + (size_t)idx * 8) = (u32x4v){0u, 0u, 0u, 0u};
    }
    const float* gam = nullptr; const float* bet = nullptr;
    if (MODE == 1) { gam = P->in[15] + l * DM; bet = P->in[16] + l * DM; }
    if (MODE >= 2) { gam = P->in[20] + l * DM; bet = P->in[21] + l * DM; }
    for (int r = blockIdx.x * 8 + wid; r < MT; r += gridDim.x * 8) {
        const float* src;
        if (MODE == 0) src = (r < TP) ? P->in[0] + (size_t)r * DM : P->in[1] + (size_t)(r - TP) * DM; else src = hb + (size_t)r * DM;
        float4 v[4];
#pragma unroll
        for (int i = 0; i < 4; ++i) v[i] = *(const float4*)(src + i * 256 + lane * 4);
        if (LN) {
            float s = 0.f;
#pragma unroll
            for (int i = 0; i < 4; ++i) s += (v[i].x + v[i].y) + (v[i].z + v[i].w);
            const float mean = wsum(s) * (1.0f / DM);
            float q = 0.f;
#pragma unroll
            for (int i = 0; i < 4; ++i) { const float a = v[i].x - mean, b = v[i].y - mean, c = v[i].z - mean, d = v[i].w - mean; q += (a * a + b * b) + (c * c + d * d); }
            const float rstd = rsqrtf(wsum(q) * (1.0f / DM) + LN_EPS);
#pragma unroll
            for (int i = 0; i < 4; ++i) {
                const float4 g4 = *(const float4*)(gam + i * 256 + lane * 4), b4 = *(const float4*)(bet + i * 256 + lane * 4);
                v[i].x = (v[i].x - mean) * rstd * g4.x + b4.x; v[i].y = (v[i].y - mean) * rstd * g4.y + b4.y;
                v[i].z = (v[i].z - mean) * rstd * g4.z + b4.z; v[i].w = (v[i].w - mean) * rstd * g4.w + b4.w;
            }
        }
        if (MODE == 3) {
            float* y = (r < TP) ? P->out + O_YP + (size_t)r * DM : P->out + O_YS + (size_t)(r - TP) * DM;
#pragma unroll
            for (int i = 0; i < 4; ++i) *(float4*)(y + i * 256 + lane * 4) = v[i];
        } else {
#pragma unroll
            for (int i = 0; i < 4; ++i) {
                *(float4*)(xf + (size_t)r * DM + i * 256 + lane * 4) = v[i];
                u32x2 w; w.x = pk2(v[i].x, v[i].y); w.y = pk2(v[i].z, v[i].w);
                *(u32x2*)(xb + (size_t)r * DM + i * 256 + lane * 4) = w;
            }
        }
        if (GATES) {
            float ga[8];
#pragma unroll
            for (int j = 0; j < 8; ++j) ga[j] = 0.f;
#pragma unroll
            for (int i = 0; i < 4; ++i) {
                const float xs[4] = {v[i].x, v[i].y, v[i].z, v[i].w};
#pragma unroll
                for (int e = 0; e < 4; ++e) {
                    const LAS float* wk = Wg + (i * 256 + lane * 4 + e) * 8;
                    const f32x4 w0 = *(const LAS f32x4*)wk, w1 = *(const LAS f32x4*)(wk + 4);
                    ga[0] += xs[e] * w0[0]; ga[1] += xs[e] * w0[1]; ga[2] += xs[e] * w0[2]; ga[3] += xs[e] * w0[3];
                    ga[4] += xs[e] * w1[0]; ga[5] += xs[e] * w1[1]; ga[6] += xs[e] * w1[2]; ga[7] += xs[e] * w1[3];
                }
            }
#pragma unroll
            for (int j = 0; j < 8; ++j) ga[j] = wsum(ga[j]);
            if (lane == 0) { *(float4*)(gt + (size_t)r * 8) = make_float4(ga[0], ga[1], ga[2], ga[3]); *(float4*)(gt + (size_t)r * 8 + 4) = make_float4(ga[4], ga[5], ga[6], ga[7]); }
        }
    }
}

template <class F> struct EpiRow {
    static constexpr bool PERM = false, AFTER_DRAIN = false; static constexpr int MID_T = 0;
    F f;
    __device__ __forceinline__ void operator()(const f32x4 (&acc)[2][2][4][2], const pg8::Unit& u, int wr, int wc, int fr, int fq) const {
        const int row0 = u.pm * 256 + wr * 64 + fr, col0 = u.pn * 256 + wc * 32 + 4 * fq;
#pragma unroll
        for (int ai = 0; ai < 2; ++ai)
#pragma unroll
            for (int m = 0; m < 4; ++m) {
#pragma unroll
                for (int bj = 0; bj < 2; ++bj)
#pragma unroll
                    for (int n = 0; n < 2; ++n) f(row0 + ai * 128 + m * 16, col0 + bj * 128 + n * 16, acc[ai][bj][m][n]);
                asm volatile("" ::: "memory");
            }
    }
};
struct EpiProj {
    static constexpr bool PERM = false, AFTER_DRAIN = false; static constexpr int MID_T = 8;
    const bf16_t* zb; bf16_t* mg;
    __device__ __forceinline__ void mid(f32x4 (&acc)[2][2][4][2], const pg8::Unit& u, int wr, int wc, int fr, int fq) const {
        const int row0 = u.pm * 256 + wr * 64 + fr, col0 = u.pn * 256 + wc * 32 + 4 * fq;
#pragma unroll
        for (int ai = 0; ai < 2; ++ai)
#pragma unroll
            for (int m = 0; m < 4; ++m) {
                const unsigned zo = ((unsigned)(row0 + ai * 128 + m * 16) * ZN + col0 + ZC_GA) * 2u;
#pragma unroll
                for (int bj = 0; bj < 2; ++bj)
#pragma unroll
                    for (int n = 0; n < 2; ++n) {
                        const u32x2 ga = *(const u32x2*)((const char*)zb + zo + (bj * 128 + n * 16) * 2), gb = *(const u32x2*)((const char*)zb + zo + (1024 + bj * 128 + n * 16) * 2);
                        f32x4 r;
                        r[0] = (1.0f + __expf(-bflo(gb.x))) * __builtin_amdgcn_rcpf(1.0f + __expf(-bflo(ga.x))); r[1] = (1.0f + __expf(-bfhi(gb.x))) * __builtin_amdgcn_rcpf(1.0f + __expf(-bfhi(ga.x)));
                        r[2] = (1.0f + __expf(-bflo(gb.y))) * __builtin_amdgcn_rcpf(1.0f + __expf(-bflo(ga.y))); r[3] = (1.0f + __expf(-bfhi(gb.y))) * __builtin_amdgcn_rcpf(1.0f + __expf(-bfhi(ga.y)));
                        acc[ai][bj][m][n] *= r;
                    }
                asm volatile("" ::: "memory");
            }
    }
    __device__ __forceinline__ void operator()(const f32x4 (&acc)[2][2][4][2], const pg8::Unit& u, int wr, int wc, int fr, int fq) const {
        const int row0 = u.pm * 256 + wr * 64 + fr, col0 = u.pn * 256 + wc * 32 + 4 * fq;
#pragma unroll
        for (int ai = 0; ai < 2; ++ai)
#pragma unroll
            for (int m = 0; m < 4; ++m) {
                const unsigned ro = (unsigned)(row0 + ai * 128 + m * 16);
                const unsigned zo = (ro * ZN + col0 + ZC_GB) * 2u, mo = (ro * DM + col0) * 2u;
#pragma unroll
                for (int bj = 0; bj < 2; ++bj)
#pragma unroll
                    for (int n = 0; n < 2; ++n) {
                        const u32x2 gb = *(const u32x2*)((const char*)zb + zo + (bj * 128 + n * 16) * 2); const f32x4 v = acc[ai][bj][m][n];
                        u32x2 w; w.x = pk2(v[0] * sigmoidf_(bflo(gb.x)), v[1] * sigmoidf_(bfhi(gb.x))); w.y = pk2(v[2] * sigmoidf_(bflo(gb.y)), v[3] * sigmoidf_(bfhi(gb.y)));
                        *(u32x2*)((char*)mg + mo + (bj * 128 + n * 16) * 2) = w;
                    }
                asm volatile("" ::: "memory");
            }
    }
};
struct FGateA {
    const bf16_t* zb; float* t1;
    __device__ __forceinline__ void operator()(int row, int col, f32x4 v) const {
        const u32x2 g = *(const u32x2*)(zb + (size_t)row * ZN + ZC_GA + col);
        f32x4 o; o[0] = sigmoidf_(bflo(g.x)) * v[0]; o[1] = sigmoidf_(bfhi(g.x)) * v[1]; o[2] = sigmoidf_(bflo(g.y)) * v[2]; o[3] = sigmoidf_(bfhi(g.y)) * v[3];
        *(f32x4*)(t1 + (size_t)row * DM + col) = o;
    }
};
struct FGateB {
    const bf16_t* zb; const float* t1; bf16_t* mg;
    __device__ __forceinline__ void operator()(int row, int col, f32x4 v) const {
        const u32x2 g = *(const u32x2*)(zb + (size_t)row * ZN + ZC_GB + col);
        const f32x4 t = *(const f32x4*)(t1 + (size_t)row * DM + col);
        u32x2 w; w.x = pk2(t[0] + sigmoidf_(bflo(g.x)) * v[0], t[1] + sigmoidf_(bfhi(g.x)) * v[1]); w.y = pk2(t[2] + sigmoidf_(bflo(g.y)) * v[2], t[3] + sigmoidf_(bfhi(g.y)) * v[3]);
        *(u32x2*)(mg + (size_t)row * DM + col) = w;
    }
};
struct FResid {
    const float* xf; float* h;
    __device__ __forceinline__ void operator()(int row, int col, f32x4 v) const {
        const unsigned o = ((unsigned)row * DM + col) * 4u;
        const f32x4 x = *(const f32x4*)((const char*)xf + o);
        *(f32x4*)((char*)h + o) = x * ALPHA + v;
    }
};
struct EpiUp {
    static constexpr bool PERM = true, AFTER_DRAIN = false; static constexpr int MID_T = 0;
    bf16_t* up; float* outp; float* outs;
    __device__ __forceinline__ void operator()(const f32x4 (&acc)[2][2][4][2], const pg8::Unit& u, int wr, int wc, int fr, int fq) const {
        const int row0 = u.pm * 256 + wr * 64 + fr, col0 = u.pn * 256 + wc * 32 + 8 * fq;
#pragma unroll
        for (int ai = 0; ai < 2; ++ai)
#pragma unroll
            for (int m = 0; m < 4; ++m) {
                const int row = row0 + ai * 128 + m * 16;
                float* fo = nullptr;
                if (row < TP) { const int pos = row & (SEQ - 1); if (pos >= SEQ - 2) fo = outp + ((size_t)(row >> 11) * 2 + (pos - (SEQ - 2))) * DUP; }
                else if (row < MT) fo = outs + ((size_t)(row - TP) * 2 + 1) * DUP;
#pragma unroll
                for (int bj = 0; bj < 2; ++bj) {
                    const f32x4 v0 = acc[ai][bj][m][0], v1 = acc[ai][bj][m][1];
                    u32x4v w; w.x = pk2(v0[0], v0[1]); w.y = pk2(v0[2], v0[3]); w.z = pk2(v1[0], v1[1]); w.w = pk2(v1[2], v1[3]);
                    *(u32x4v*)(up + (size_t)row * DUP + col0 + bj * 128) = w;
                    if (fo) { *(f32x4*)(fo + col0 + bj * 128) = v0; *(f32x4*)(fo + col0 + bj * 128 + 4) = v1; }
                }
            }
    }
};

template <class F>
__device__ void micro_gemm(LAS unsigned char* lds, const bf16_t* A, int lda, const bf16_t* Bt, int ldb, int K, const F& f) {
    int tid_ = threadIdx.x; asm volatile("" : "+v"(tid_)); const int tid = tid_, wid = __builtin_amdgcn_readfirstlane(tid >> 6), lane = tid & 63, g = lane >> 4, lr = lane & 15;
    LAS f32x4* red = (LAS f32x4*)lds;
    for (int id = blockIdx.x; id < 256; id += gridDim.x) {
        const int mb = id >> 6, nb = id & 63, ks = K >> 3, kb = wid * ks;
        const bf16_t* a0 = A + (size_t)(TP + mb * 32 + lr) * lda + kb + 8 * g; const bf16_t* a1 = a0 + (size_t)16 * lda;
        const bf16_t* b0 = Bt + (size_t)(nb * 16 + lr) * ldb + kb + 8 * g;
        f32x4 c0 = {0.f, 0.f, 0.f, 0.f}, c1 = {0.f, 0.f, 0.f, 0.f};
        for (int k = 0; k < ks; k += 32) {
            const bf16x8 fa0 = *(const bf16x8*)(a0 + k), fa1 = *(const bf16x8*)(a1 + k), fb = *(const bf16x8*)(b0 + k);
            c0 = mfma16(fb, fa0, c0); c1 = mfma16(fb, fa1, c1);
        }
        red[(wid * 2 + 0) * 64 + lane] = c0; red[(wid * 2 + 1) * 64 + lane] = c1;
        bar();
        if (wid < 2) {
            f32x4 s = {0.f, 0.f, 0.f, 0.f};
#pragma unroll
            for (int w = 0; w < 8; ++w) s += red[(w * 2 + wid) * 64 + lane];
            f(TP + mb * 32 + wid * 16 + lr, nb * 16 + 4 * g, s);
        }
        bar();
    }
}

__device__ void mlstm_pass1(KP P, int l, LAS unsigned char* lds) {
    int tid_ = threadIdx.x; asm volatile("" : "+v"(tid_)); const int tid = tid_, wid = __builtin_amdgcn_readfirstlane(tid >> 6), lane = tid & 63, g = lane >> 4, lr = lane & 15;
    constexpr int KST = 544, VST = 96, OFF_V = 128 * KST, OFF_G = OFF_V + 128 * VST;
    LAS unsigned char* Kimg = lds; LAS unsigned char* Vimg = lds + OFF_V;
    LAS float* garr = (LAS float*)(lds + OFF_G);
    LAS float* nred = garr + 2 * 400;
    const bf16_t* zb = (const bf16_t*)(P->ws + WS_ZB); const float* gt = (const float*)(P->ws + WS_GT); float* gtab = (float*)(P->ws + WS_GTAB);
    bf16_t* CSt = (bf16_t*)(P->ws + WS_CST); float* NSt = (float*)(P->ws + WS_NST);
    for (int item = blockIdx.x; item < 256; item += gridDim.x) {
        const int bh = item >> 3, j = item & 7, b = bh >> 2, h = bh & 3;
        const size_t row0 = (size_t)b * SEQ;
        const float bi = P->in[8][l * 4 + h], bfg = P->in[9][l * 4 + h];
        f32x4 acc[2][2];
#pragma unroll
        for (int a = 0; a < 2; ++a)
#pragma unroll
            for (int c = 0; c < 2; ++c) acc[a][c] = (f32x4){0.f, 0.f, 0.f, 0.f};
        float nreg = 0.f, m_c = 0.f;
        u32x4v kreg[8]; u32x4v vreg; float gi0 = 0.f, gf0 = 0.f, gi1 = 0.f, gf1 = 0.f;
        {
            const size_t r0 = row0;
#pragma unroll
            for (int i = 0; i < 8; ++i) { const int vec = tid + 512 * i, row = vec >> 5, cv = vec & 31; kreg[i] = *(const u32x4v*)(zb + (r0 + row) * ZN + ZC_K + h * 256 + cv * 8); }
            { const int row = tid >> 2, cv = tid & 3; vreg = *(const u32x4v*)(zb + (r0 + row) * ZN + ZC_V + h * 256 + 32 * j + cv * 8); }
            if (wid == 0) { const float* gp = gt + (r0 + 2 * lane) * 8; gi0 = gp[h]; gf0 = gp[4 + h]; gi1 = gp[8 + h]; gf1 = gp[12 + h]; }
        }
        for (int c = 0; c < 16; ++c) {
            const size_t r0 = row0 + (size_t)c * 128;
            LAS float* ga = garr + (c & 1) * 400; LAS float* gM = ga + 128; LAS float* gw = ga + 256; LAS float* misc = ga + 384;
            if (wid == 0) {
                const float li0 = gi0 + bi, li1 = gi1 + bi, lf0 = logsigmoidf_(gf0 + bfg), lf1 = logsigmoidf_(gf1 + bfg);
                float sc = lf0 + lf1;
#pragma unroll
                for (int o = 1; o < 64; o <<= 1) { const float t = __shfl_up(sc, o); if (lane >= o) sc += t; }
                const float b1 = sc, b0 = sc - lf1;
                const float a0 = li0 - b0, a1 = li1 - b1;
                float sm = fmaxf(a0, a1);
#pragma unroll
                for (int o = 1; o < 64; o <<= 1) { const float t = __shfl_up(sm, o); if (lane >= o) sm = fmaxf(sm, t); }
                float ex = __shfl_up(sm, 1); if (lane == 0) ex = -INFINITY;
                const float M0 = fmaxf(m_c, fmaxf(ex, a0)), M1 = fmaxf(m_c, sm);
                const float blast = __shfl(b1, 63), Mlast = __shfl(M1, 63);
                ga[2 * lane] = a0; ga[2 * lane + 1] = a1; gM[2 * lane] = M0; gM[2 * lane + 1] = M1;
                gw[2 * lane] = __expf(a0 - Mlast); gw[2 * lane + 1] = __expf(a1 - Mlast);
                if (lane == 0) { misc[0] = __expf(m_c - Mlast); misc[1] = Mlast; }
                if (j == 0) {
                    *(float4*)(gtab + ((r0 + 2 * lane) * 4 + h) * 4) = make_float4(a0, M0, __expf(m_c - M0), __expf(-(b0 + M0)));
                    *(float4*)(gtab + ((r0 + 2 * lane + 1) * 4 + h) * 4) = make_float4(a1, M1, __expf(m_c - M1), __expf(-(b1 + M1)));
                }
                m_c = blast + Mlast;
            }
            {
                bf16_t* cs = CSt + ((size_t)(bh * 16 + c) << 16);
#pragma unroll
                for (int kt = 0; kt < 2; ++kt)
#pragma unroll
                    for (int vt = 0; vt < 2; ++vt) {
                        const int v = 32 * j + 16 * vt + lr, k = 32 * wid + 16 * kt + 4 * g;
                        u32x2 w; w.x = pk2(acc[kt][vt][0], acc[kt][vt][1]); w.y = pk2(acc[kt][vt][2], acc[kt][vt][3]);
                        *(u32x2*)(cs + v * 256 + k) = w;
                    }
                if (j == 0 && tid < 256) NSt[(size_t)(bh * 16 + c) * 256 + tid] = nreg;
            }
            bar();
            const float decay = misc[0];
#pragma unroll
            for (int i = 0; i < 8; ++i) { const int vec = tid + 512 * i, row = vec >> 5, cv = vec & 31; *(LAS u32x4v*)(Kimg + row * KST + cv * 16) = kreg[i]; }
            {
                const int row = tid >> 2, cv = tid & 3; const float w = gw[row];
                u32x4v o; o.x = pk2(bflo(vreg.x) * w, bfhi(vreg.x) * w); o.y = pk2(bflo(vreg.y) * w, bfhi(vreg.y) * w); o.z = pk2(bflo(vreg.z) * w, bfhi(vreg.z) * w); o.w = pk2(bflo(vreg.w) * w, bfhi(vreg.w) * w);
                *(LAS u32x4v*)(Vimg + row * VST + cv * 16) = o;
            }
            if (c + 1 < 16) {
                const size_t r1 = r0 + 128;
#pragma unroll
                for (int i = 0; i < 8; ++i) { const int vec = tid + 512 * i, row = vec >> 5, cv = vec & 31; kreg[i] = *(const u32x4v*)(zb + (r1 + row) * ZN + ZC_K + h * 256 + cv * 8); }
                { const int row = tid >> 2, cv = tid & 3; vreg = *(const u32x4v*)(zb + (r1 + row) * ZN + ZC_V + h * 256 + 32 * j + cv * 8); }
                if (wid == 0) { const float* gp = gt + (r1 + 2 * lane) * 8; gi0 = gp[h]; gf0 = gp[4 + h]; gi1 = gp[8 + h]; gf1 = gp[12 + h]; }
            }
            bar();
#pragma unroll
            for (int kt = 0; kt < 2; ++kt)
#pragma unroll
                for (int vt = 0; vt < 2; ++vt) acc[kt][vt] *= decay;
#pragma unroll
            for (int ss = 0; ss < 4; ++ss) {
                const int sr = 32 * ss + 4 * g + (lr >> 2);
                bf16x8 fa[2], fb[2];
#pragma unroll
                for (int kt = 0; kt < 2; ++kt) {
                    const LAS unsigned char* p = Kimg + sr * KST + (32 * wid + 16 * kt + 4 * (lr & 3)) * 2;
                    fa[kt] = cat8(tr_read(p), tr_read(p + 16 * KST));
                }
#pragma unroll
                for (int vt = 0; vt < 2; ++vt) {
                    const LAS unsigned char* p = Vimg + sr * VST + (16 * vt + 4 * (lr & 3)) * 2;
                    fb[vt] = cat8(tr_read(p), tr_read(p + 16 * VST));
                }
#pragma unroll
                for (int kt = 0; kt < 2; ++kt)
#pragma unroll
                    for (int vt = 0; vt < 2; ++vt) acc[kt][vt] = mfma16(fa[kt], fb[vt], acc[kt][vt]);
            }
            {
                const int k = tid & 255, hs = tid >> 8; float s = 0.f;
                for (int si = 0; si < 64; ++si) { const int sidx = hs * 64 + si; s += gw[sidx] * bf2f(*(const LAS unsigned short*)(Kimg + sidx * KST + k * 2)); }
                nred[hs * 256 + k] = s;
            }
            bar();
            if (tid < 256) nreg = decay * nreg + nred[tid] + nred[256 + tid];
        }
        {
            float* Co = P->out + O_CP + ((size_t)((l * NBATCH + b) * HM + h) << 16);
#pragma unroll
            for (int kt = 0; kt < 2; ++kt)
#pragma unroll
                for (int vt = 0; vt < 2; ++vt)
#pragma unroll
                    for (int e = 0; e < 4; ++e) Co[(size_t)(32 * wid + 16 * kt + 4 * g + e) * 256 + 32 * j + 16 * vt + lr] = acc[kt][vt][e];
            if (j == 0 && tid < 256) P->out[O_NP + (size_t)((l * NBATCH + b) * HM + h) * 256 + tid] = nreg;
            if (j == 0 && tid == 0) P->out[O_MP + (l * NBATCH + b) * HM + h] = m_c;
        }
        bar();
    }
}

__device__ void mlstm_sample(KP P, int l, LAS unsigned char* lds) {
    int tid_ = threadIdx.x; asm volatile("" : "+v"(tid_)); const int tid = tid_, wid = __builtin_amdgcn_readfirstlane(tid >> 6), lane = tid & 63;
    LAS float* sq = (LAS float*)lds; LAS float* sk = sq + 256; LAS float* sv = sk + 256; LAS float* sn0 = sv + 256; LAS float* sred = sn0 + 256; LAS float* red = sred + 64;
    const bf16_t* zb = (const bf16_t*)(P->ws + WS_ZB); const float* gt = (const float*)(P->ws + WS_GT); bf16_t* AB = (bf16_t*)(P->ws + WS_AB);
    for (int item = blockIdx.x; item < NSMP * HM; item += gridDim.x) {
        const int b = item >> 2, h = item & 3; const size_t row = TP + b; const size_t sidx = (size_t)(l * NSMP + b) * HM + h;
        if (tid < 256) {
            sq[tid] = bf2f(zb[row * ZN + ZC_Q + h * 256 + tid]); sk[tid] = bf2f(zb[row * ZN + ZC_K + h * 256 + tid]); sv[tid] = bf2f(zb[row * ZN + ZC_V + h * 256 + tid]);
            sn0[tid] = P->in[4][sidx * 256 + tid];
        }
        bar();
        const float li = gt[row * 8 + h] + P->in[8][l * 4 + h], lf = logsigmoidf_(gt[row * 8 + 4 + h] + P->in[9][l * 4 + h]), m0 = P->in[5][sidx];
        const float m_t = fmaxf(lf + m0, li), sc = expf(lf + m0 - m_t), wi = expf(li - m_t);
        float pqk = 0.f, pqn = 0.f;
        if (tid < 256) { pqk = sq[tid] * sk[tid]; pqn = sq[tid] * sn0[tid]; }
        pqk = wsum(pqk); pqn = wsum(pqn);
        if (lane == 0) { sred[wid] = pqk; sred[8 + wid] = pqn; }
        const float* C0 = P->in[3] + (sidx << 16); float* C1 = P->out + O_CS + (sidx << 16);
        float4 qc = make_float4(0.f, 0.f, 0.f, 0.f); const f32x4 vv_ = *(const LAS f32x4*)(sv + 4 * lane); const float4 vv = make_float4(vv_[0], vv_[1], vv_[2], vv_[3]);
#pragma unroll 8
        for (int i = 0; i < 32; ++i) {
            const int k = wid + 8 * i; const float4 cv = *(const float4*)(C0 + k * 256 + 4 * lane); const float qk_ = sq[k], kw = wi * sk[k];
            qc.x += qk_ * cv.x; qc.y += qk_ * cv.y; qc.z += qk_ * cv.z; qc.w += qk_ * cv.w;
            *(float4*)(C1 + k * 256 + 4 * lane) = make_float4(sc * cv.x + kw * vv.x, sc * cv.y + kw * vv.y, sc * cv.z + kw * vv.z, sc * cv.w + kw * vv.w);
        }
        *(LAS f32x4*)(red + wid * 256 + 4 * lane) = (f32x4){qc.x, qc.y, qc.z, qc.w};
        bar();
        float qk = 0.f, qn = 0.f;
#pragma unroll
        for (int w = 0; w < 4; ++w) { qk += sred[w]; qn += sred[8 + w]; }
        float hcv = 0.f;
        if (tid < 256) {
            float qC = 0.f;
#pragma unroll
            for (int w = 0; w < 8; ++w) qC += red[w * 256 + tid];
            const float s = qk * wi, numer = s * sv[tid] + sc * qC, den = s + sc * qn;
            hcv = numer / fmaxf(fabsf(den), expf(-m_t));
            P->out[O_NS + sidx * 256 + tid] = sc * sn0[tid] + wi * sk[tid];
        }
        if (tid == 0) P->out[O_MS + sidx] = m_t;
        float s1 = wsum(hcv);
        bar();
        if (lane == 0) sred[wid] = s1;
        bar();
        const float mu = (sred[0] + sred[1] + sred[2] + sred[3]) * (1.0f / 256.0f);
        const float dv = (tid < 256) ? hcv - mu : 0.f;
        float s2 = wsum(dv * dv);
        bar();
        if (lane == 0) sred[wid] = s2;
        bar();
        const float rstd = rsqrtf((sred[0] + sred[1] + sred[2] + sred[3]) * (1.0f / 256.0f) + LN_EPS);
        if (tid < 256) {
            const float og = bf2f(zb[row * ZN + ZC_O + h * 256 + tid]);
            AB[row * KPR + 512 + h * 256 + tid] = f2bf(sigmoidf_(og) * (dv * rstd * P->in[11][l * DM + h * 256 + tid]));
        }
        bar();
    }
}

__device__ __forceinline__ void unpack8(const u32x4v w, float (&o)[8]) { o[0] = bflo(w.x); o[1] = bfhi(w.x); o[2] = bflo(w.y); o[3] = bfhi(w.y); o[4] = bflo(w.z); o[5] = bfhi(w.z); o[6] = bflo(w.w); o[7] = bfhi(w.w); }
__device__ __forceinline__ void ld8f(const float* p, float (&o)[8]) { const float4 a = *(const float4*)p, b = *(const float4*)(p + 4); o[0] = a.x; o[1] = a.y; o[2] = a.z; o[3] = a.w; o[4] = b.x; o[5] = b.y; o[6] = b.z; o[7] = b.w; }
__device__ __forceinline__ void st8f(float* p, const float (&o)[8]) { *(float4*)p = make_float4(o[0], o[1], o[2], o[3]); *(float4*)(p + 4) = make_float4(o[4], o[5], o[6], o[7]); }
__device__ __forceinline__ u32x4v pack8(const float (&o)[8]) { u32x4v w; w.x = pk2(o[0], o[1]); w.y = pk2(o[2], o[3]); w.z = pk2(o[4], o[5]); w.w = pk2(o[6], o[7]); return w; }

__device__ void conv_branch(KP P, int l) {
    int tid_ = threadIdx.x; asm volatile("" : "+v"(tid_)); const int tid = tid_;
    const bf16_t* zb = (const bf16_t*)(P->ws + WS_ZB); bf16_t* AB = (bf16_t*)(P->ws + WS_AB);
    const float* wc = P->in[10] + (size_t)l * 3 * DCONV;
    for (int task = blockIdx.x * 512 + tid; task < (TP / 8) * 64 + NSMP * 64; task += gridDim.x * 512) {
        if (task < (TP / 8) * 64) {
            const int cv = task & 63, tg = task >> 6; const size_t t0 = (size_t)tg * 8; const int pos0 = (int)(t0 & (SEQ - 1)), b = (int)(t0 >> 11);
            float w0[8], w1[8], w2[8], pm2[8], pm1[8];
            ld8f(wc + cv * 8, w0); ld8f(wc + DCONV + cv * 8, w1); ld8f(wc + 2 * DCONV + cv * 8, w2);
            if (pos0 == 0) {
#pragma unroll
                for (int e = 0; e < 8; ++e) { pm2[e] = 0.f; pm1[e] = 0.f; }
            } else {
                float c_[8], x_[8];
                unpack8(*(const u32x4v*)(zb + (t0 - 2) * ZN + ZC_CG + cv * 8), c_); unpack8(*(const u32x4v*)(zb + (t0 - 2) * ZN + ZC_XV + cv * 8), x_);
#pragma unroll
                for (int e = 0; e < 8; ++e) pm2[e] = c_[e] * x_[e];
                unpack8(*(const u32x4v*)(zb + (t0 - 1) * ZN + ZC_CG + cv * 8), c_); unpack8(*(const u32x4v*)(zb + (t0 - 1) * ZN + ZC_XV + cv * 8), x_);
#pragma unroll
                for (int e = 0; e < 8; ++e) pm1[e] = c_[e] * x_[e];
            }
#pragma unroll
            for (int r = 0; r < 8; ++r) {
                const size_t row = t0 + r; float c_[8], x_[8], g_[8], o_[8], p_[8];
                unpack8(*(const u32x4v*)(zb + row * ZN + ZC_CG + cv * 8), c_); unpack8(*(const u32x4v*)(zb + row * ZN + ZC_XV + cv * 8), x_); unpack8(*(const u32x4v*)(zb + row * ZN + ZC_BG + cv * 8), g_);
#pragma unroll
                for (int e = 0; e < 8; ++e) { p_[e] = c_[e] * x_[e]; o_[e] = g_[e] * (w0[e] * pm2[e] + w1[e] * pm1[e] + w2[e] * p_[e]); pm2[e] = pm1[e]; pm1[e] = p_[e]; }
                *(u32x4v*)(AB + row * KPR + cv * 8) = pack8(o_);
                if (pos0 + r >= SEQ - 2) st8f(P->out + O_SCP + ((size_t)(l * NBATCH + b) * 2 + (pos0 + r - (SEQ - 2))) * DCONV + cv * 8, p_);
            }
        } else {
            const int t2 = task - (TP / 8) * 64, cv = t2 & 63, b = t2 >> 6; const size_t row = TP + b;
            float w0[8], w1[8], w2[8], pm2[8], pm1[8], c_[8], x_[8], g_[8], o_[8], p_[8];
            ld8f(wc + cv * 8, w0); ld8f(wc + DCONV + cv * 8, w1); ld8f(wc + 2 * DCONV + cv * 8, w2);
            const float* cache = P->in[2] + ((size_t)(l * NSMP + b) * 2) * DCONV + cv * 8;
            ld8f(cache, pm2); ld8f(cache + DCONV, pm1);
            unpack8(*(const u32x4v*)(zb + row * ZN + ZC_CG + cv * 8), c_); unpack8(*(const u32x4v*)(zb + row * ZN + ZC_XV + cv * 8), x_); unpack8(*(const u32x4v*)(zb + row * ZN + ZC_BG + cv * 8), g_);
#pragma unroll
            for (int e = 0; e < 8; ++e) { p_[e] = c_[e] * x_[e]; o_[e] = g_[e] * (w0[e] * pm2[e] + w1[e] * pm1[e] + w2[e] * p_[e]); }
            *(u32x4v*)(AB + row * KPR + cv * 8) = pack8(o_);
            float* so = P->out + O_SCS + ((size_t)(l * NSMP + b) * 2) * DCONV + cv * 8;
            st8f(so, pm1); st8f(so + DCONV, p_);
        }
    }
}

__device__ void mlstm_pass2(KP P, int l, LAS unsigned char* lds) {
    int tid_ = threadIdx.x; asm volatile("" : "+v"(tid_)); const int tid = tid_, wid = __builtin_amdgcn_readfirstlane(tid >> 6), lane = tid & 63, g = lane >> 4, lr = lane & 15;
    constexpr int CST = 528, KST = 528, VST = 544, OFF_V = 128 * KST, OFF_A = 137216;
    LAS float* sa = (LAS float*)(lds + OFF_A); LAS float* sM = sa + 128; LAS float* ssc = sM + 128; LAS float* sfl = ssc + 128; LAS float* sn = sfl + 128;
    const bf16_t* zb = (const bf16_t*)(P->ws + WS_ZB); const float* gtab = (const float*)(P->ws + WS_GTAB); bf16_t* AB = (bf16_t*)(P->ws + WS_AB);
    const bf16_t* CSt = (const bf16_t*)(P->ws + WS_CST); const float* NSt = (const float*)(P->ws + WS_NST);
    for (int item = blockIdx.x; item < 512; item += gridDim.x) {
        const int bh = item >> 4, c = item & 15, b = bh >> 2, h = bh & 3;
        const size_t r0 = (size_t)b * SEQ + (size_t)c * 128;
        {
            const bf16_t* cs = CSt + ((size_t)(bh * 16 + c) << 16);
#pragma unroll
            for (int hb_ = 0; hb_ < 2; ++hb_) {
                u32x4v t[8];
#pragma unroll
                for (int i = 0; i < 8; ++i) t[i] = *(const u32x4v*)((const char*)cs + (unsigned)(tid + 512 * (hb_ * 8 + i)) * 16u);
#pragma unroll
                for (int i = 0; i < 8; ++i) { const int vec = tid + 512 * (hb_ * 8 + i), row = vec >> 5, cv = vec & 31; *(LAS u32x4v*)(lds + row * CST + cv * 16) = t[i]; }
                asm volatile("" ::: "memory");
            }
            if (tid < 128) { const float4 t = *(const float4*)(gtab + ((r0 + tid) * 4 + h) * 4); sa[tid] = t.x; sM[tid] = t.y; ssc[tid] = t.z; sfl[tid] = t.w; }
            if (tid < 256) sn[tid] = NSt[(size_t)(bh * 16 + c) * 256 + tid];
        }
        bf16x8 Qf[8];
        {
            const bf16_t* qp = zb + (r0 + 16 * wid + lr) * ZN + ZC_Q + h * 256 + 8 * g;
#pragma unroll
            for (int ks = 0; ks < 8; ++ks) Qf[ks] = *(const bf16x8*)(qp + 32 * ks);
        }
        bar();
        f32x4 acc[16];
#pragma unroll
        for (int vt = 0; vt < 16; ++vt) acc[vt] = (f32x4){0.f, 0.f, 0.f, 0.f};
#pragma unroll
        for (int vt = 0; vt < 16; ++vt)
#pragma unroll
            for (int ks = 0; ks < 8; ++ks) {
                const bf16x8 fa = *(const LAS bf16x8*)(lds + (16 * vt + lr) * CST + (32 * ks + 8 * g) * 2);
                acc[vt] = mfma16(fa, Qf[ks], acc[vt]);
            }
        float qn = 0.f;
#pragma unroll
        for (int ks = 0; ks < 8; ++ks)
#pragma unroll
            for (int e = 0; e < 8; ++e) qn += bf2f((unsigned short)Qf[ks][e]) * sn[32 * ks + 8 * g + e];
        qn += __shfl_xor(qn, 16); qn += __shfl_xor(qn, 32);
        const int tl = 16 * wid + lr;
        const float sc_t = ssc[tl], M_t = sM[tl], fl_t = sfl[tl];
#pragma unroll
        for (int vt = 0; vt < 16; ++vt) acc[vt] *= sc_t;
        bar();
        {
            const unsigned kb0 = (unsigned)(((tid >> 5)) * ZN + ZC_K + h * 256 + (tid & 31) * 8) * 2u;
            const char* zr = (const char*)(zb + r0 * ZN);
#pragma unroll
            for (int hb_ = 0; hb_ < 2; ++hb_) {
                u32x4v t[4], u[4];
#pragma unroll
                for (int i = 0; i < 4; ++i) { t[i] = *(const u32x4v*)(zr + kb0 + (unsigned)((hb_ * 4 + i) * 16 * ZN * 2)); u[i] = *(const u32x4v*)(zr + kb0 + (unsigned)((hb_ * 4 + i) * 16 * ZN * 2 + (ZC_V - ZC_K) * 2)); }
#pragma unroll
                for (int i = 0; i < 4; ++i) { const int row = (tid >> 5) + (hb_ * 4 + i) * 16, cv = tid & 31; *(LAS u32x4v*)(lds + row * KST + cv * 16) = t[i]; *(LAS u32x4v*)(lds + OFF_V + row * VST + cv * 16) = u[i]; }
                asm volatile("" ::: "memory");
            }
        }
        bar();
        float rs = 0.f;
#pragma unroll
        for (int pp = 0; pp < 4; ++pp) {
            if (2 * pp <= wid) {
                f32x4 s0 = {0.f, 0.f, 0.f, 0.f}, s1 = {0.f, 0.f, 0.f, 0.f};
                const bool two = (2 * pp + 1 <= wid);
#pragma unroll
                for (int ks = 0; ks < 8; ++ks) {
                    const bf16x8 k0 = *(const LAS bf16x8*)(lds + (32 * pp + lr) * KST + (32 * ks + 8 * g) * 2);
                    s0 = mfma16(k0, Qf[ks], s0);
                    if (two) { const bf16x8 k1 = *(const LAS bf16x8*)(lds + (32 * pp + 16 + lr) * KST + (32 * ks + 8 * g) * 2); s1 = mfma16(k1, Qf[ks], s1); }
                }
                const f32x4 a0 = *(const LAS f32x4*)(sa + 32 * pp + 4 * g), a1 = *(const LAS f32x4*)(sa + 32 * pp + 16 + 4 * g);
                float p0[4], p1[4];
#pragma unroll
                for (int e = 0; e < 4; ++e) {
                    const int sA = 32 * pp + 4 * g + e, sB = sA + 16;
                    p0[e] = (sA <= tl) ? s0[e] * __expf(a0[e] - M_t) : 0.f;
                    p1[e] = (sB <= tl) ? s1[e] * __expf(a1[e] - M_t) : 0.f;
                    rs += p0[e] + p1[e];
                }
                bf16x8 Pf;
                {
                    const unsigned w0 = pk2(p0[0], p0[1]), w1 = pk2(p0[2], p0[3]), w2 = pk2(p1[0], p1[1]), w3 = pk2(p1[2], p1[3]);
                    Pf[0] = (short)(w0 & 0xffff); Pf[1] = (short)(w0 >> 16); Pf[2] = (short)(w1 & 0xffff); Pf[3] = (short)(w1 >> 16);
                    Pf[4] = (short)(w2 & 0xffff); Pf[5] = (short)(w2 >> 16); Pf[6] = (short)(w3 & 0xffff); Pf[7] = (short)(w3 >> 16);
                }
                const LAS unsigned char* vb = lds + OFF_V + (32 * pp + 4 * g + (lr >> 2)) * VST + (4 * (lr & 3)) * 2;
#pragma unroll
                for (int vt = 0; vt < 16; ++vt) {
                    const bf16x8 fv = cat8(tr_read(vb + vt * 32), tr_read(vb + vt * 32 + 16 * VST));
                    acc[vt] = mfma16(fv, Pf, acc[vt]);
                }
            }
        }
        rs += __shfl_xor(rs, 16); rs += __shfl_xor(rs, 32);
        const float den = rs + sc_t * qn, inv = 1.0f / fmaxf(fabsf(den), fl_t);
        float s1 = 0.f;
#pragma unroll
        for (int vt = 0; vt < 16; ++vt) { acc[vt] *= inv; s1 += (acc[vt][0] + acc[vt][1]) + (acc[vt][2] + acc[vt][3]); }
        s1 += __shfl_xor(s1, 16); s1 += __shfl_xor(s1, 32);
        const float mu = s1 * (1.0f / 256.0f);
        float s2 = 0.f;
#pragma unroll
        for (int vt = 0; vt < 16; ++vt) { acc[vt] -= mu; s2 += (acc[vt][0] * acc[vt][0] + acc[vt][1] * acc[vt][1]) + (acc[vt][2] * acc[vt][2] + acc[vt][3] * acc[vt][3]); }
        s2 += __shfl_xor(s2, 16); s2 += __shfl_xor(s2, 32);
        const float rstd = rsqrtf(s2 * (1.0f / 256.0f) + LN_EPS);
        {
            const size_t row = r0 + tl; const float* mg_ = P->in[11] + l * DM + h * 256;
#pragma unroll
            for (int vt = 0; vt < 16; ++vt) {
                const int v0 = 16 * vt + 4 * g;
                const float4 gm = *(const float4*)(mg_ + v0); const u32x2 og = *(const u32x2*)(zb + row * ZN + ZC_O + h * 256 + v0);
                u32x2 w;
                w.x = pk2(sigmoidf_(bflo(og.x)) * (acc[vt][0] * rstd * gm.x), sigmoidf_(bfhi(og.x)) * (acc[vt][1] * rstd * gm.y));
                w.y = pk2(sigmoidf_(bflo(og.y)) * (acc[vt][2] * rstd * gm.z), sigmoidf_(bfhi(og.y)) * (acc[vt][3] * rstd * gm.w));
                *(u32x2*)(AB + row * KPR + 512 + h * 256 + v0) = w;
            }
        }
        bar();
    }
}

__device__ void conv_act(KP P, int l) {
    int tid_ = threadIdx.x; asm volatile("" : "+v"(tid_)); const int tid = tid_;
    const bf16_t* up = (const bf16_t*)(P->ws + WS_UP); bf16_t* act = (bf16_t*)(P->ws + WS_ACT);
    const float* wc = P->in[18] + (size_t)l * 3 * DUP;
    constexpr int NCV = DFF / 8;
    constexpr int NT_P = (TP / 8) * NCV, NT_S = NSMP * NCV;
    for (int task = blockIdx.x * 512 + tid; task < NT_P + NT_S; task += gridDim.x * 512) {
        if (task < NT_P) {
            const int cv = task % NCV, tg = task / NCV; const size_t t0 = (size_t)tg * 8; const int pos0 = (int)(t0 & (SEQ - 1));
            float wg0[8], wg1[8], wg2[8], wu0[8], wu1[8], wu2[8], g2[8], g1[8], u2[8], u1[8];
            ld8f(wc + cv * 8, wg0); ld8f(wc + DUP + cv * 8, wg1); ld8f(wc + 2 * DUP + cv * 8, wg2);
            ld8f(wc + DFF + cv * 8, wu0); ld8f(wc + DUP + DFF + cv * 8, wu1); ld8f(wc + 2 * DUP + DFF + cv * 8, wu2);
            if (pos0 == 0) {
#pragma unroll
                for (int e = 0; e < 8; ++e) { g2[e] = 0.f; g1[e] = 0.f; u2[e] = 0.f; u1[e] = 0.f; }
            } else {
                unpack8(*(const u32x4v*)(up + (t0 - 2) * DUP + cv * 8), g2); unpack8(*(const u32x4v*)(up + (t0 - 1) * DUP + cv * 8), g1);
                unpack8(*(const u32x4v*)(up + (t0 - 2) * DUP + DFF + cv * 8), u2); unpack8(*(const u32x4v*)(up + (t0 - 1) * DUP + DFF + cv * 8), u1);
            }
#pragma unroll
            for (int r = 0; r < 8; ++r) {
                const size_t row = t0 + r; float g0[8], u0[8], o_[8];
                unpack8(*(const u32x4v*)(up + row * DUP + cv * 8), g0); unpack8(*(const u32x4v*)(up + row * DUP + DFF + cv * 8), u0);
#pragma unroll
                for (int e = 0; e < 8; ++e) {
                    const float gc = wg0[e] * g2[e] + wg1[e] * g1[e] + wg2[e] * g0[e], uc = wu0[e] * u2[e] + wu1[e] * u1[e] + wu2[e] * u0[e];
                    o_[e] = gc * sigmoidf_(gc) * uc; g2[e] = g1[e]; g1[e] = g0[e]; u2[e] = u1[e]; u1[e] = u0[e];
                }
                *(u32x4v*)(act + row * DFF + cv * 8) = pack8(o_);
            }
        } else {
            const int t2 = task - NT_P, cv = t2 % NCV, b = t2 / NCV; const size_t row = TP + b;
            float wg0[8], wg1[8], wg2[8], wu0[8], wu1[8], wu2[8], g2[8], g1[8], u2[8], u1[8], g0[8], u0[8], o_[8];
            ld8f(wc + cv * 8, wg0); ld8f(wc + DUP + cv * 8, wg1); ld8f(wc + 2 * DUP + cv * 8, wg2);
            ld8f(wc + DFF + cv * 8, wu0); ld8f(wc + DUP + DFF + cv * 8, wu1); ld8f(wc + 2 * DUP + DFF + cv * 8, wu2);
            const float* cache = P->in[6] + ((size_t)(l * NSMP + b) * 2) * DUP;
            ld8f(cache + cv * 8, g2); ld8f(cache + DUP + cv * 8, g1); ld8f(cache + DFF + cv * 8, u2); ld8f(cache + DUP + DFF + cv * 8, u1);
            unpack8(*(const u32x4v*)(up + row * DUP + cv * 8), g0); unpack8(*(const u32x4v*)(up + row * DUP + DFF + cv * 8), u0);
#pragma unroll
            for (int e = 0; e < 8; ++e) {
                const float gc = wg0[e] * g2[e] + wg1[e] * g1[e] + wg2[e] * g0[e], uc = wu0[e] * u2[e] + wu1[e] * u1[e] + wu2[e] * u0[e];
                o_[e] = gc * sigmoidf_(gc) * uc;
            }
            *(u32x4v*)(act + row * DFF + cv * 8) = pack8(o_);
            float* fo = P->out + O_FS + ((size_t)(l * NSMP + b) * 2) * DUP;
            st8f(fo + cv * 8, g1); st8f(fo + DFF + cv * 8, u1);
        }
    }
}

__global__ void __launch_bounds__(512) fwd_megakernel(Params Pv) {
    extern __shared__ __attribute__((aligned(16))) unsigned char smem[];
    LAS unsigned char* lds0 = (LAS unsigned char*)smem;
    cg::grid_group grid = cg::this_grid();
    KP P0 = (KP)__builtin_amdgcn_kernarg_segment_ptr();
    const int ph_lo = Pv.ph_lo, ph_hi = Pv.ph_hi;
    const bool multi = (ph_hi - ph_lo) > 1;
    for (int ph = ph_lo; ph < ph_hi; ++ph) {
        KP P = P0; asm volatile("" : "+s"(P));
        LAS unsigned char* lds = lds0; asm volatile("" : "+s"(lds));
        int bid = blockIdx.x; asm volatile("" : "+s"(bid));
        bf16_t* xb = (bf16_t*)(P->ws + WS_XB); float* xf = (float*)(P->ws + WS_XF); float* hb = (float*)(P->ws + WS_HB); bf16_t* zb = (bf16_t*)(P->ws + WS_ZB);
        bf16_t* AB = (bf16_t*)(P->ws + WS_AB); bf16_t* mg = (bf16_t*)(P->ws + WS_MG); bf16_t* up = (bf16_t*)(P->ws + WS_UP); bf16_t* act = (bf16_t*)(P->ws + WS_ACT);

        if (ph == 0) {
            prep_weights(P, lds);
            row_phase<0>(P, 0, lds);
        } else {
            const int l = (ph - 1) / 10, s = (ph - 1) % 10;
            const bf16_t* WinT = (const bf16_t*)(P->ws + WS_WIN) + (size_t)l * ZN * DM; const bf16_t* WprT = (const bf16_t*)(P->ws + WS_WPR) + (size_t)l * DM * KPR;
            const bf16_t* WmxT = (const bf16_t*)(P->ws + WS_WMX) + (size_t)l * DM * DM; const bf16_t* WupT = (const bf16_t*)(P->ws + WS_WUP) + (size_t)l * DUP * DM;
            const bf16_t* WdnT = (const bf16_t*)(P->ws + WS_WDN) + (size_t)l * DM * DFF;
            if (s == 0) {
                pg8::Gemm g{xb, WinT, MP, ZN, DM}; pg8::StaticOrder S; S.init(MP, ZN, gridDim.x, bid);
                pg8::EpiBf16<0> E{zb, ZN, nullptr, 0, 0};
                pg8::gemm_phase<pg8::EpiBf16<0>, pg8::StaticOrder>(lds, g, S, E, nullptr);
            } else if (s == 1) {
                mlstm_pass1(P, l, lds);
                conv_branch(P, l);
                mlstm_sample(P, l, lds);
            } else if (s == 2) {
                mlstm_pass2(P, l, lds);
            } else if (s == 3) {
                {
                    pg8::Gemm g{AB, WprT, TP, DM, KPR}; pg8::StaticOrder S; S.init(TP, DM, gridDim.x, bid);
                    EpiProj E{zb, mg};
                    pg8::gemm_phase<EpiProj, pg8::StaticOrder>(lds, g, S, E, nullptr);
                }
                bar();
                { FGateA fa{zb, hb}; micro_gemm(lds, AB, KPR, WprT, KPR, 512, fa); }
                { FGateB fb{zb, hb, mg}; micro_gemm(lds, AB + 512, KPR, WprT + 512, KPR, 1024, fb); }
            } else if (s == 4) {
                FResid fr_{xf, hb};
                {
                    pg8::Gemm g{mg, WmxT, TP, DM, DM}; pg8::StaticOrder S; S.init(TP, DM, gridDim.x, bid);
                    EpiRow<FResid> E{fr_};
                    pg8::gemm_phase<EpiRow<FResid>, pg8::StaticOrder>(lds, g, S, E, nullptr);
                }
                bar();
                micro_gemm(lds, mg, DM, WmxT, DM, DM, fr_);
            } else if (s == 5) {
                row_phase<1>(P, l, lds);
            } else if (s == 6) {
                pg8::Gemm g{xb, WupT, MP, DUP, DM}; pg8::StaticOrder S; S.init(MP, DUP, gridDim.x, bid);
                EpiUp E{up, P->out + O_FP + (size_t)l * NBATCH * 2 * DUP, P->out + O_FS + (size_t)l * NSMP * 2 * DUP};
                pg8::gemm_phase<EpiUp, pg8::StaticOrder>(lds, g, S, E, nullptr);
            } else if (s == 7) {
                conv_act(P, l);
            } else if (s == 8) {
                FResid fr_{xf, hb};
                {
                    pg8::Gemm g{act, WdnT, TP, DM, DFF}; pg8::StaticOrder S; S.init(TP, DM, gridDim.x, bid);
                    EpiRow<FResid> E{fr_};
                    pg8::gemm_phase<EpiRow<FResid>, pg8::StaticOrder>(lds, g, S, E, nullptr);
                }
                bar();
                micro_gemm(lds, act, DFF, WdnT, DFF, DFF, fr_);
            } else {
                if (l + 1 < DEPTH) row_phase<2>(P, l, lds); else row_phase<3>(P, l, lds);
            }
        }
        if (multi && ph + 1 < ph_hi) grid.sync();
    }
}

extern "C" void kernel_launch(void* const* d_in, const int* in_sizes, int n_in, void* d_out, int out_size, void* d_ws, size_t ws_size, hipStream_t stream) {
    static int grid_blocks = 0;
    if (grid_blocks == 0) {
        int dev = 0, cus = 0, per_cu = 0;
        hipGetDevice(&dev);
        hipDeviceGetAttribute(&cus, hipDeviceAttributeMultiprocessorCount, dev);
        if (hipFuncSetAttribute((const void*)fwd_megakernel, hipFuncAttributeMaxDynamicSharedMemorySize, LDS_BYTES) != hipSuccess) fprintf(stderr, "hipFuncSetAttribute failed\n");
        hipOccupancyMaxActiveBlocksPerMultiprocessor(&per_cu, (const void*)fwd_megakernel, 512, LDS_BYTES);
        if (per_cu < 1) { fprintf(stderr, "occupancy query says %d blocks/CU\n", per_cu); per_cu = 1; }
        grid_blocks = cus * 1;
        (void)hipGetLastError();
        if (ws_size < WS_END) fprintf(stderr, "workspace too small: %zu < %zu\n", ws_size, (size_t)WS_END);
    }
    Params p{};
    for (int i = 0; i < 22; ++i) p.in[i] = (const float*)d_in[i];
    p.out = (float*)d_out; p.ws = (unsigned char*)d_ws; p.ph_lo = 0; p.ph_hi = 1 + 10 * DEPTH;
    void* args[] = {&p};
    hipError_t e = hipLaunchCooperativeKernel((const void*)fwd_megakernel, dim3(grid_blocks), dim3(512), args, LDS_BYTES, stream);
    if (e != hipSuccess) fprintf(stderr, "cooperative launch failed: %s (grid %d)\n", hipGetErrorString(e), grid_blocks);
}
```

```cpp
#include <hip/hip_runtime.h>
#include <hip/hip_cooperative_groups.h>
#include <cstdio>
namespace cg = cooperative_groups;
#include <hip/hip_runtime.h>
namespace pg8 {
#define PG8_LAS __attribute__((address_space(3)))
typedef unsigned short bf16_t;
typedef short bf16x8 __attribute__((ext_vector_type(8)));
typedef float f32x4 __attribute__((ext_vector_type(4)));
typedef unsigned u32x4 __attribute__((ext_vector_type(4)));
constexpr int BM = 256, BK = 64, HALF = 128, HTB = HALF * BK * 2  , STAGE_BYTES = 8 * HTB, NXCD = 8, WGM = 8;

__host__ __device__ __forceinline__ int lds_byte(int r, int c) { const int st = (r >> 4) * 2 + (c >> 5), rr = r & 15, cc = c & 31, ob = rr * 64 + cc * 2; return st * 1024 + (ob ^ (((ob >> 9) & 1) << 5)); }
__host__ __device__ __forceinline__ void stage_rc(int b, int& R, int& C) { const int st = b / 1024, sb = b % 1024, swz = sb ^ (((sb >> 9) & 1) << 5); R = (st >> 1) * 16 + swz / 64; C = (st & 1) * 32 + (swz % 64) / 2; }
__host__ __device__ __forceinline__ int perm32(int rho) { const int n = rho >> 4, i = rho & 15; return 8 * (i >> 2) + 4 * n + (i & 3); }

struct Unit { int pm, pn; };
struct Gemm { const bf16_t* A; const bf16_t* Bt; int M, N, K; };

struct StaticOrder {
    int nM, nN, nwg, G, c;
    __host__ __device__ void init(int M, int N, int G_, int c_) { nM = M / BM; nN = N / BM; nwg = nM * nN; G = G_; c = c_; }
    __host__ __device__ bool next(int i, Unit& u) const {
        const long L = (long)i * G + c; if (L >= nwg) return false;
        int wgid = (int)L; { const int q = nwg / NXCD, r = nwg % NXCD, xcd = wgid % NXCD, off = wgid / NXCD; wgid = (xcd < r ? xcd * (q + 1) : r * (q + 1) + (xcd - r) * q) + off; }
        const int nig = WGM * nN, gid = wgid / nig, fm = gid * WGM, gsz = (nM - fm) < WGM ? (nM - fm) : WGM;
        u.pm = fm + ((wgid % nig) % gsz); u.pn = (wgid % nig) / gsz; return true;
    }
    __device__ __forceinline__ void a_ready(const Unit&) const {}
    __device__ __forceinline__ void done(const Unit&) const {}
};
__device__ __forceinline__ unsigned cvt_pk_bf16(float lo, float hi) { unsigned r; asm volatile("v_cvt_pk_bf16_f32 %0, %1, %2" : "=v"(r) : "v"(lo), "v"(hi)); return r; }
typedef float f32x2 __attribute__((ext_vector_type(2)));
__device__ __forceinline__ f32x2 gelu_pk(f32x2 v) {
    const f32x2 av = __builtin_elementwise_abs(v), d = av * 0.2316418882f + 1.0f;
    f32x2 t; t.x = __builtin_amdgcn_rcpf(d.x); t.y = __builtin_amdgcn_rcpf(d.y);
    f32x2 q = t * 0.5307027145f + (-0.7265760135f); q = q * t + 0.7107068705f; q = q * t + (-0.142248368f); q = q * t + 0.127414796f; q = q * t;
    const f32x2 s = (v * v) * (-0.72134752044f);
    f32x2 e; e.x = __builtin_amdgcn_exp2f(s.x); e.y = __builtin_amdgcn_exp2f(s.y);
    const f32x2 m = v * (q * e), r = v - m;
    f32x2 o; o.x = v.x < 0.f ? m.x : r.x; o.y = v.y < 0.f ? m.y : r.y; return o;
}

struct EpiF32 {
    static constexpr bool PERM = false, AFTER_DRAIN = false; static constexpr int MID_T = 0;
    float* C; int ldc; const float* bias;
    __device__ __forceinline__ void operator()(const f32x4 (&acc)[2][2][4][2], const Unit& u, int wr, int wc, int fr, int fq) const {
        const int row0 = u.pm * BM + wr * 64 + fr, col0 = u.pn * BM + wc * 32 + 4 * fq;
        f32x4 bv[2][2];
#pragma unroll
        for (int bj = 0; bj < 2; ++bj)
#pragma unroll
            for (int n = 0; n < 2; ++n) bv[bj][n] = bias ? *(const f32x4*)(bias + col0 + bj * HALF + n * 16) : (f32x4){0.f, 0.f, 0.f, 0.f};
#pragma unroll
        for (int ai = 0; ai < 2; ++ai)
#pragma unroll
            for (int m = 0; m < 4; ++m) { float* rowp = C + (size_t)(row0 + ai * HALF + m * 16) * ldc + col0;
#pragma unroll
                for (int bj = 0; bj < 2; ++bj)
#pragma unroll
                    for (int n = 0; n < 2; ++n) *(f32x4*)(rowp + bj * HALF + n * 16) = acc[ai][bj][m][n] + bv[bj][n]; }
    }
};
template <int ACT  > struct EpiBf16 {
    static constexpr bool PERM = true, AFTER_DRAIN = false; static constexpr int MID_T = 0;
    bf16_t* O; int ldc; const float* bias; int split_cols; size_t split_stride;
    __device__ __forceinline__ void operator()(const f32x4 (&acc)[2][2][4][2], const Unit& u, int wr, int wc, int fr, int fq) const {
        const int row0 = u.pm * BM + wr * 64 + fr; int colt = u.pn * BM; bf16_t* base = O;
        if (split_cols) { const int t = colt / split_cols; base += (size_t)t * split_stride; colt -= t * split_cols; }
        const int col0 = colt + wc * 32 + 8 * fq, bcol0 = u.pn * BM + wc * 32 + 8 * fq;
        f32x4 bv[2][2];
#pragma unroll
        for (int bj = 0; bj < 2; ++bj)
#pragma unroll
            for (int n = 0; n < 2; ++n) bv[bj][n] = bias ? *(const f32x4*)(bias + bcol0 + bj * HALF + 4 * n) : (f32x4){0.f, 0.f, 0.f, 0.f};
#pragma unroll
        for (int ai = 0; ai < 2; ++ai)
#pragma unroll
            for (int m = 0; m < 4; ++m) { bf16_t* rowp = base + (size_t)(row0 + ai * HALF + m * 16) * ldc + col0;
#pragma unroll
                for (int bj = 0; bj < 2; ++bj) { f32x4 v0 = acc[ai][bj][m][0] + bv[bj][0], v1 = acc[ai][bj][m][1] + bv[bj][1];
                    if (ACT == 1) { f32x2 a = gelu_pk((f32x2){v0[0], v0[1]}), b = gelu_pk((f32x2){v0[2], v0[3]}), c = gelu_pk((f32x2){v1[0], v1[1]}), d = gelu_pk((f32x2){v1[2], v1[3]});
                        v0 = (f32x4){a.x, a.y, b.x, b.y}; v1 = (f32x4){c.x, c.y, d.x, d.y}; }
                    if (ACT == 2) {
#pragma unroll
                        for (int j = 0; j < 4; ++j) { v0[j] = 0.5f * v0[j] * (1.0f + erff(v0[j] * 0.70710678f)); v1[j] = 0.5f * v1[j] * (1.0f + erff(v1[j] * 0.70710678f)); } }
                    u32x4 w; w.x = cvt_pk_bf16(v0[0], v0[1]); w.y = cvt_pk_bf16(v0[2], v0[3]); w.z = cvt_pk_bf16(v1[0], v1[1]); w.w = cvt_pk_bf16(v1[2], v1[3]);
                    *(u32x4*)(rowp + bj * HALF) = w; } }
    }
};
template <class Epi, class Sched, bool STAMP = false>
__device__ __forceinline__ void gemm_phase(PG8_LAS unsigned char* lds, const Gemm g, const Sched& S, const Epi& E, unsigned long long* stamps) {
    int tid_ = threadIdx.x; asm volatile("" : "+v"(tid_)); const int tid = tid_, wid = __builtin_amdgcn_readfirstlane(tid >> 6), lane = tid & 63, wr = wid >> 2, wc = wid & 3, fr = lane & 15, fq = lane >> 4;
    const int K = g.K, nt = K / BK;
    int ts_lo = 0, ts_hi = 0, nts = 0; const unsigned long long rt_entry = STAMP ? (unsigned long long)wall_clock64() : 0ull;
#define PG8_STAMP() do { if (STAMP && wid == 0 && nts < 64) { const unsigned long long _c = (unsigned long long)clock64(); \
        ts_lo = (lane == nts) ? (int)(unsigned)_c : ts_lo; ts_hi = (lane == nts) ? (int)(unsigned)(_c >> 32) : ts_hi; ++nts; } } while (0)
    PG8_STAMP();
    unsigned voffA[2], voffB[2];
#pragma unroll
    for (int i = 0; i < 2; ++i) { int R, C; stage_rc(tid * 16 + i * 8192, R, C); const int Rb = Epi::PERM ? ((R & ~31) + perm32(R & 31)) : R;
        voffA[i] = (unsigned)(R * K + C) * 2u; voffB[i] = (unsigned)(Rb * K + C) * 2u; }
    const size_t kstep = (size_t)(BK * 2);
    const size_t hstep = (size_t)HALF * K * 2;
    const size_t tstep = 2 * hstep;
    const unsigned ldsw = (unsigned)wid * 1024u;
    const int aoff = lds_byte(wr * 64 + fr, fq * 8), boff = lds_byte(wc * 32 + fr, fq * 8);
#define PG8_SA(b, h) (((b) * 2 + (h)) * HTB)
#define PG8_SB(b, h) ((4 + (b) * 2 + (h)) * HTB)
#define PG8_STAGE(bufoff, gbase, voff) do { _Pragma("unroll") for (int _i = 0; _i < 2; ++_i) \
        __builtin_amdgcn_global_load_lds((const unsigned*)((const char*)(gbase) + (voff)[_i]), (PG8_LAS unsigned*)(lds + (bufoff) + ldsw + _i * 8192), 16, 0, 0); } while (0)
#define PG8_LDA(dst, b, h) do { _Pragma("unroll") for (int m = 0; m < 4; ++m) _Pragma("unroll") for (int k = 0; k < 2; ++k) dst[m][k] = *(const PG8_LAS bf16x8*)(lds + PG8_SA(b, h) + aoff + m * 2048 + k * 1024); } while (0)
#define PG8_LDB(dst, b, h) do { _Pragma("unroll") for (int n = 0; n < 2; ++n) _Pragma("unroll") for (int k = 0; k < 2; ++k) dst[n][k] = *(const PG8_LAS bf16x8*)(lds + PG8_SB(b, h) + boff + n * 2048 + k * 1024); } while (0)
#define PG8_MMA(ai, bj, At, Bt) do { __builtin_amdgcn_s_setprio(1); _Pragma("unroll") for (int m = 0; m < 4; ++m) _Pragma("unroll") for (int n = 0; n < 2; ++n) _Pragma("unroll") for (int k = 0; k < 2; ++k) \
        acc[ai][bj][m][n] = __builtin_amdgcn_mfma_f32_16x16x32_bf16(Bt[n][k], At[m][k], acc[ai][bj][m][n], 0, 0, 0); __builtin_amdgcn_s_setprio(0); } while (0)
#define PG8_WAIT_V(n) asm volatile("s_waitcnt vmcnt(" #n ")" ::: "memory")
#define PG8_WAIT_L(n) asm volatile("s_waitcnt lgkmcnt(" #n ")" ::: "memory")
#define PG8_BAR __builtin_amdgcn_s_barrier()
#define PG8_SCHED __builtin_amdgcn_sched_barrier(0)
    Unit cur, nxt; int ui = 0;
    if (!S.next(0, cur)) return;
    f32x4 acc[2][2][4][2];
#pragma unroll
    for (int a = 0; a < 2; ++a)
#pragma unroll
        for (int b = 0; b < 2; ++b)
#pragma unroll
            for (int m = 0; m < 4; ++m)
#pragma unroll
                for (int n = 0; n < 2; ++n) acc[a][b][m][n] = (f32x4){0.f, 0.f, 0.f, 0.f};
    bf16x8 At[4][2], B0[2][2], B1[2][2];
    const char* cA = (const char*)g.A + (size_t)cur.pm * tstep; const char* cB = (const char*)g.Bt + (size_t)cur.pn * tstep;
    S.a_ready(cur);
    PG8_STAGE(PG8_SB(0, 0), cB, voffB); PG8_STAGE(PG8_SA(0, 0), cA, voffA); PG8_STAGE(PG8_SB(0, 1), cB + hstep, voffB); PG8_STAGE(PG8_SA(0, 1), cA + hstep, voffA);
    if (wr == 1) PG8_BAR;
    PG8_WAIT_V(4); PG8_BAR;
    PG8_STAGE(PG8_SB(1, 0), cB + kstep, voffB); PG8_STAGE(PG8_SA(1, 0), cA + kstep, voffA); PG8_STAGE(PG8_SB(1, 1), cB + hstep + kstep, voffB);
    PG8_WAIT_V(6); PG8_BAR;
    PG8_STAMP();
    for (;;) {
        const bool has_next = S.next(ui + 1, nxt);
        const char* nA = has_next ? (const char*)g.A + (size_t)nxt.pm * tstep : cA; const char* nB = has_next ? (const char*)g.Bt + (size_t)nxt.pn * tstep : cB;
        for (int t = 0; t < nt; t += 2) {
            if constexpr (Epi::MID_T > 0) { if (t == Epi::MID_T) E.mid(acc, cur, wr, wc, fr, fq); }
            const bool last = (t == nt - 2);
            const char* a1 = cA + (size_t)(t + 1) * kstep;
            const char* a2 = last ? nA : cA + (size_t)(t + 2) * kstep; const char* b2 = last ? nB : cB + (size_t)(t + 2) * kstep;
            const char* a3 = a2 + kstep; const char* b3 = b2 + kstep;
            if (last && has_next) S.a_ready(nxt);
            PG8_LDB(B0, 0, 0); PG8_SCHED; PG8_LDA(At, 0, 0); PG8_STAGE(PG8_SA(1, 1), a1 + hstep, voffA);
            PG8_WAIT_L(8); PG8_BAR; PG8_WAIT_L(0); PG8_MMA(0, 0, At, B0); PG8_BAR; PG8_SCHED;
            PG8_LDB(B1, 0, 1); PG8_STAGE(PG8_SB(0, 0), b2, voffB);
            PG8_BAR; PG8_WAIT_L(0); PG8_MMA(0, 1, At, B1); PG8_BAR;
            PG8_LDA(At, 0, 1); PG8_STAGE(PG8_SA(0, 0), a2, voffA);
            PG8_BAR; PG8_WAIT_L(0); PG8_MMA(1, 0, At, B0); PG8_BAR; PG8_SCHED;
            PG8_STAGE(PG8_SB(0, 1), b2 + hstep, voffB);
            PG8_WAIT_V(6); PG8_BAR; PG8_MMA(1, 1, At, B1); PG8_BAR;
            PG8_LDB(B0, 1, 0); PG8_SCHED; PG8_LDA(At, 1, 0); PG8_STAGE(PG8_SA(0, 1), a2 + hstep, voffA);
            PG8_WAIT_L(8); PG8_BAR; PG8_WAIT_L(0); PG8_MMA(0, 0, At, B0); PG8_BAR; PG8_SCHED;
            PG8_LDB(B1, 1, 1); PG8_STAGE(PG8_SB(1, 0), b3, voffB);
            PG8_BAR; PG8_WAIT_L(0); PG8_MMA(0, 1, At, B1); PG8_BAR;
            PG8_LDA(At, 1, 1); PG8_STAGE(PG8_SA(1, 0), a3, voffA);
            PG8_BAR; PG8_WAIT_L(0); PG8_MMA(1, 0, At, B0); PG8_BAR; PG8_SCHED;
            PG8_STAGE(PG8_SB(1, 1), b3 + hstep, voffB);
            PG8_WAIT_V(6); PG8_BAR; PG8_MMA(1, 1, At, B1); PG8_BAR;
        }
        PG8_STAMP();
        if constexpr (!Epi::AFTER_DRAIN) { E(acc, cur, wr, wc, fr, fq); S.done(cur); }
        PG8_STAMP();
        if (!has_next) break;
#pragma unroll
        for (int a = 0; a < 2; ++a)
#pragma unroll
            for (int b = 0; b < 2; ++b)
#pragma unroll
                for (int m = 0; m < 4; ++m)
#pragma unroll
                    for (int n = 0; n < 2; ++n) acc[a][b][m][n] = (f32x4){0.f, 0.f, 0.f, 0.f};
        cur = nxt; cA = nA; cB = nB; ++ui;
    }
    PG8_WAIT_V(0);
    if (wr == 0) PG8_BAR;
    PG8_BAR;
    if constexpr (Epi::AFTER_DRAIN) { E.fused(acc, cur, wr, wc, fr, fq, lds, wid, lane); S.done(cur); }
    PG8_STAMP();
    if (STAMP && wid == 0) { stamps[lane] = lane < nts ? (((unsigned long long)(unsigned)ts_hi << 32) | (unsigned)ts_lo) : 0ull;
        if (lane == 62) stamps[62] = rt_entry; if (lane == 63) stamps[63] = (unsigned long long)wall_clock64(); }
#undef PG8_STAMP
#undef PG8_SA
#undef PG8_SB
#undef PG8_STAGE
#undef PG8_LDA
#undef PG8_LDB
#undef PG8_MMA
#undef PG8_WAIT_V
#undef PG8_WAIT_L
#undef PG8_BAR
#undef PG8_SCHED
}
}

#define LAS __attribute__((address_space(3)))
using pg8::bf16_t; using pg8::bf16x8; using pg8::f32x4;
typedef unsigned u32x2 __attribute__((ext_vector_type(2)));
typedef unsigned u32x4v __attribute__((ext_vector_type(4)));
typedef short s16x4 __attribute__((ext_vector_type(4)));

constexpr int DM = 1024, SEQ = 2048, NBATCH = 8, TP = NBATCH * SEQ, NSMP = 128, MT = TP + NSMP, MP = 16640;
constexpr int DEPTH = 4, DCONV = 512, HM = 4, DH = 256, DFF = 2816, DIN = 7688, ZN = 7680, DUP = 2 * DFF, KPR = 1536;
constexpr float LN_EPS = 1e-5f;
constexpr float ALPHA = 1.681792830507429f;
constexpr int ZC_BG = 0, ZC_CG = 512, ZC_XV = 1024, ZC_Q = 1536, ZC_K = 2560, ZC_V = 3584, ZC_O = 4608, ZC_GA = 5632, ZC_GB = 6656;
constexpr long O_YP = 0, O_YS = 16777216, O_SCP = 16908288, O_SCS = 16941056, O_CP = 17465344, O_CS = 25853952, O_NP = 160071680, O_NS = 160104448,
               O_MP = 160628736, O_MS = 160628864, O_FP = 160630912, O_FS = 160991360;
constexpr size_t al256(size_t x) { return (x + 255) & ~(size_t)255; }
constexpr size_t WS_WIN = 0;
constexpr size_t WS_WPR = al256(WS_WIN + (size_t)DEPTH * ZN * DM * 2);
constexpr size_t WS_WMX = al256(WS_WPR + (size_t)DEPTH * DM * KPR * 2);
constexpr size_t WS_WUP = al256(WS_WMX + (size_t)DEPTH * DM * DM * 2);
constexpr size_t WS_WDN = al256(WS_WUP + (size_t)DEPTH * DUP * DM * 2);
constexpr size_t WS_XF = al256(WS_WDN + (size_t)DEPTH * DM * DFF * 2);
constexpr size_t WS_XB = al256(WS_XF + (size_t)MP * DM * 4);
constexpr size_t WS_HB = al256(WS_XB + (size_t)MP * DM * 2);
constexpr size_t WS_ZB = al256(WS_HB + (size_t)MP * DM * 4);
constexpr size_t WS_GT = al256(WS_ZB + (size_t)MP * ZN * 2);
constexpr size_t WS_GTAB = al256(WS_GT + (size_t)MP * 8 * 4);
constexpr size_t WS_AB = al256(WS_GTAB + (size_t)TP * 16 * 4);
constexpr size_t WS_MG = al256(WS_AB + (size_t)MP * KPR * 2);
constexpr size_t WS_UP = al256(WS_MG + (size_t)MP * DM * 2);
constexpr size_t WS_ACT = al256(WS_UP + (size_t)MP * DUP * 2);
constexpr size_t WS_CST = al256(WS_ACT + (size_t)MP * DFF * 2);
constexpr size_t WS_NST = al256(WS_CST + (size_t)32 * 16 * 256 * 256 * 2);
constexpr int XCD_BAR_WORDS_C = 3456;
constexpr size_t WS_BAR = al256(WS_NST + (size_t)32 * 16 * 256 * 4);
constexpr size_t WS_END = al256(WS_BAR + (size_t)XCD_BAR_WORDS_C * 4);
constexpr int LDS_BYTES = 147456;
#ifndef DUP_MASK
#define DUP_MASK 0
#endif

struct Params {
    const float* in[22];
    float* out;
    unsigned char* ws;
    int ph_lo, ph_hi;
};
typedef const __attribute__((address_space(4))) Params* KP;

__device__ __forceinline__ float bf2f(unsigned short b) { return __uint_as_float(((unsigned)b) << 16); }
__device__ __forceinline__ float bflo(unsigned w) { return __uint_as_float(w << 16); }
__device__ __forceinline__ float bfhi(unsigned w) { return __uint_as_float(w & 0xffff0000u); }
__device__ __forceinline__ unsigned pk2(float lo, float hi) { return pg8::cvt_pk_bf16(lo, hi); }
__device__ __forceinline__ unsigned short f2bf(float x) { return (unsigned short)(pg8::cvt_pk_bf16(x, 0.f) & 0xffffu); }
__device__ __forceinline__ float sigmoidf_(float x) { return __builtin_amdgcn_rcpf(1.0f + __expf(-x)); }
__device__ __forceinline__ float logsigmoidf_(float x) { return (x >= 0.f) ? -log1pf(expf(-x)) : (x - log1pf(expf(x))); }
__device__ __forceinline__ float wsum(float v) {
#pragma unroll
    for (int o = 32; o >= 1; o >>= 1) v += __shfl_xor(v, o);
    return v;
}
__device__ __forceinline__ void bar() { __syncthreads(); }
__device__ __forceinline__ s16x4 tr_read(const LAS unsigned char* p) {
    return __builtin_bit_cast(s16x4, __builtin_amdgcn_ds_read_tr16_b64_v4i16((LAS s16x4*)p));
}
__device__ __forceinline__ bf16x8 cat8(s16x4 a, s16x4 b) { bf16x8 r; r[0] = a[0]; r[1] = a[1]; r[2] = a[2]; r[3] = a[3]; r[4] = b[0]; r[5] = b[1]; r[6] = b[2]; r[7] = b[3]; return r; }
__device__ __forceinline__ f32x4 mfma16(bf16x8 a, bf16x8 b, f32x4 c) { return __builtin_amdgcn_mfma_f32_16x16x32_bf16(a, b, c, 0, 0, 0); }

__device__ void prep_weights(KP P, LAS unsigned char* lds) {
    LAS float* T = (LAS float*)lds;
    constexpr int T_IN = 16 * 120, T_PA = 8 * 16, T_PB = 16 * 16, T_MX = 16 * 16, T_UP = 16 * 88, T_DN = 44 * 16;
    constexpr int T_L = T_IN + T_PA + T_PB + T_MX + T_UP + T_DN;
    int tid_ = threadIdx.x; asm volatile("" : "+v"(tid_)); const int tid = tid_;
    for (int it = blockIdx.x; it < DEPTH * T_L; it += gridDim.x) {
        const int l = it / T_L; int r = it % T_L;
        const float* src; bf16_t* dst; int ldsrc, lddst, k0, srcn0, dn0, dk0; float scale = 1.0f;
        if (r < T_IN) {
            const int kt = r & 15, nt = r >> 4; k0 = kt * 64; dn0 = nt * 64; srcn0 = dn0 < 5632 ? dn0 : dn0 + 8; dk0 = k0;
            src = P->in[7] + (size_t)l * DM * DIN; ldsrc = DIN; dst = (bf16_t*)(P->ws + WS_WIN) + (size_t)l * ZN * DM; lddst = DM;
            if (dn0 >= ZC_K && dn0 < ZC_V) scale = 0.0625f;
        } else if ((r -= T_IN) < T_PA) {
            const int kt = r & 7, nt = r >> 3; k0 = kt * 64; dn0 = nt * 64; srcn0 = dn0; dk0 = k0;
            src = P->in[12] + (size_t)l * DCONV * DM; ldsrc = DM; dst = (bf16_t*)(P->ws + WS_WPR) + (size_t)l * DM * KPR; lddst = KPR;
        } else if ((r -= T_PA) < T_PB) {
            const int kt = r & 15, nt = r >> 4; k0 = kt * 64; dn0 = nt * 64; srcn0 = dn0; dk0 = 512 + k0;
            src = P->in[13] + (size_t)l * DM * DM; ldsrc = DM; dst = (bf16_t*)(P->ws + WS_WPR) + (size_t)l * DM * KPR; lddst = KPR;
        } else if ((r -= T_PB) < T_MX) {
            const int kt = r & 15, nt = r >> 4; k0 = kt * 64; dn0 = nt * 64; srcn0 = dn0; dk0 = k0;
            src = P->in[14] + (size_t)l * DM * DM; ldsrc = DM; dst = (bf16_t*)(P->ws + WS_WMX) + (size_t)l * DM * DM; lddst = DM;
        } else if ((r -= T_MX) < T_UP) {
            const int kt = r & 15, nt = r >> 4; k0 = kt * 64; dn0 = nt * 64; srcn0 = dn0; dk0 = k0;
            src = P->in[17] + (size_t)l * DM * DUP; ldsrc = DUP; dst = (bf16_t*)(P->ws + WS_WUP) + (size_t)l * DUP * DM; lddst = DM;
        } else {
            r -= T_UP;
            const int kt = r % 44, nt = r / 44; k0 = kt * 64; dn0 = nt * 64; srcn0 = dn0; dk0 = k0;
            src = P->in[19] + (size_t)l * DFF * DM; ldsrc = DM; dst = (bf16_t*)(P->ws + WS_WDN) + (size_t)l * DM * DFF; lddst = DFF;
        }
#pragma unroll
        for (int i = 0; i < 2; ++i) {
            const int idx = tid + i * 512, kk = idx >> 4, nv = idx & 15;
            const float4 v = *(const float4*)(src + (size_t)(k0 + kk) * ldsrc + srcn0 + nv * 4);
            T[(nv * 4 + 0) * 65 + kk] = v.x; T[(nv * 4 + 1) * 65 + kk] = v.y; T[(nv * 4 + 2) * 65 + kk] = v.z; T[(nv * 4 + 3) * 65 + kk] = v.w;
        }
        bar();
        {
            const int nn = tid >> 3, kc = tid & 7;
            const LAS float* t = T + nn * 65 + kc * 8;
            u32x4v w;
            w.x = pk2(t[0] * scale, t[1] * scale); w.y = pk2(t[2] * scale, t[3] * scale); w.z = pk2(t[4] * scale, t[5] * scale); w.w = pk2(t[6] * scale, t[7] * scale);
            *(u32x4v*)(dst + (size_t)(dn0 + nn) * lddst + dk0 + kc * 8) = w;
        }
        bar();
    }
}

template <int MODE>
__device__ void row_phase(KP P, int l, LAS unsigned char* lds) {
    int tid_ = threadIdx.x; asm volatile("" : "+v"(tid_)); const int tid = tid_, wid = __builtin_amdgcn_readfirstlane(tid >> 6), lane = tid & 63;
    constexpr bool LN = MODE != 0, GATES = (MODE == 0 || MODE == 2);
    LAS float* Wg = (LAS float*)lds;
    float* xf = (float*)(P->ws + WS_XF); bf16_t* xb = (bf16_t*)(P->ws + WS_XB); const float* hb = (const float*)(P->ws + WS_HB); float* gt = (float*)(P->ws + WS_GT);
    if (GATES) {
        const int gl = (MODE == 0) ? 0 : l + 1;
        const float* w = P->in[7] + (size_t)gl * DM * DIN + 5632;
        for (int idx = tid; idx < 8192; idx += 512) Wg[idx] = w[(size_t)(idx >> 3) * DIN + (idx & 7)];
        bar();
    }
    if (MODE == 0) {
        for (int idx = blockIdx.x * 512 + tid; idx < (MP - MT) * DM / 8; idx += gridDim.x * 512) *(u32x4v*)(xb + (size_t)MT * DM + (size_t)idx * 8) = (u32x4v){0u, 0u, 0u, 0u};
    }
    const float* gam = nullptr; const float* bet = nullptr;
    if (MODE == 1) { gam = P->in[15] + l * DM; bet = P->in[16] + l * DM; }
    if (MODE >= 2) { gam = P->in[20] + l * DM; bet = P->in[21] + l * DM; }
    for (int r = blockIdx.x * 8 + wid; r < MT; r += gridDim.x * 8) {
        const float* src;
        if (MODE == 0) src = (r < TP) ? P->in[0] + (size_t)r * DM : P->in[1] + (size_t)(r - TP) * DM; else src = hb + (size_t)r * DM;
        float4 v[4];
#pragma unroll
        for (int i = 0; i < 4; ++i) v[i] = *(const float4*)(src + i * 256 + lane * 4);
        if (LN) {
            float s = 0.f;
#pragma unroll
            for (int i = 0; i < 4; ++i) s += (v[i].x + v[i].y) + (v[i].z + v[i].w);
            const float mean = wsum(s) * (1.0f / DM);
            float q = 0.f;
#pragma unroll
            for (int i = 0; i < 4; ++i) { const float a = v[i].x - mean, b = v[i].y - mean, c = v[i].z - mean, d = v[i].w - mean; q += (a * a + b * b) + (c * c + d * d); }
            const float rstd = rsqrtf(wsum(q) * (1.0f / DM) + LN_EPS);
#pragma unroll
            for (int i = 0; i < 4; ++i) {
                const float4 g4 = *(const float4*)(gam + i * 256 + lane * 4), b4 = *(const float4*)(bet + i * 256 + lane * 4);
                v[i].x = (v[i].x - mean) * rstd * g4.x + b4.x; v[i].y = (v[i].y - mean) * rstd * g4.y + b4.y;
                v[i].z = (v[i].z - mean) * rstd * g4.z + b4.z; v[i].w = (v[i].w - mean) * rstd * g4.w + b4.w;
            }
        }
        if (MODE == 3) {
            float* y = (r < TP) ? P->out + O_YP + (size_t)r * DM : P->out + O_YS + (size_t)(r - TP) * DM;
#pragma unroll
            for (int i = 0; i < 4; ++i) *(float4*)(y + i * 256 + lane * 4) = v[i];
        } else {
#pragma unroll
            for (int i = 0; i < 4; ++i) {
                *(float4*)(xf + (size_t)r * DM + i * 256 + lane * 4) = v[i];
                u32x2 w; w.x = pk2(v[i].x, v[i].y); w.y = pk2(v[i].z, v[i].w);
                *(u32x2*)(xb + (size_t)r * DM + i * 256 + lane * 4) = w;
            }
        }
        if (GATES) {
            float ga[8];
#pragma unroll
            for (int j = 0; j < 8; ++j) ga[j] = 0.f;
#pragma unroll
            for (int i = 0; i < 4; ++i) {
                const float xs[4] = {v[i].x, v[i].y, v[i].z, v[i].w};
#pragma unroll
                for (int e = 0; e < 4; ++e) {
                    const LAS float* wk = Wg + (i * 256 + lane * 4 + e) * 8;
                    const f32x4 w0 = *(const LAS f32x4*)wk, w1 = *(const LAS f32x4*)(wk + 4);
                    ga[0] += xs[e] * w0[0]; ga[1] += xs[e] * w0[1]; ga[2] += xs[e] * w0[2]; ga[3] += xs[e] * w0[3];
                    ga[4] += xs[e] * w1[0]; ga[5] += xs[e] * w1[1]; ga[6] += xs[e] * w1[2]; ga[7] += xs[e] * w1[3];
                }
            }
#pragma unroll
            for (int j = 0; j < 8; ++j) ga[j] = wsum(ga[j]);
            if (lane == 0) { *(float4*)(gt + (size_t)r * 8) = make_float4(ga[0], ga[1], ga[2], ga[3]); *(float4*)(gt + (size_t)r * 8 + 4) = make_float4(ga[4], ga[5], ga[6], ga[7]); }
        }
    }
}

template <class F> struct EpiRow {
    static constexpr bool PERM = false, AFTER_DRAIN = false; static constexpr int MID_T = 0;
    F f;
    __device__ __forceinline__ void operator()(const f32x4 (&acc)[2][2][4][2], const pg8::Unit& u, int wr, int wc, int fr, int fq) const {
        const int row0 = u.pm * 256 + wr * 64 + fr, col0 = u.pn * 256 + wc * 32 + 4 * fq;
#pragma unroll
        for (int ai = 0; ai < 2; ++ai)
#pragma unroll
            for (int m = 0; m < 4; ++m) {
#pragma unroll
                for (int bj = 0; bj < 2; ++bj)
#pragma unroll
                    for (int n = 0; n < 2; ++n) f(row0 + ai * 128 + m * 16, col0 + bj * 128 + n * 16, acc[ai][bj][m][n]);
                asm volatile("" ::: "memory");
            }
    }
};
struct EpiProj {
    static constexpr bool PERM = false, AFTER_DRAIN = false; static constexpr int MID_T = 8;
    const bf16_t* zb; bf16_t* mg;
    __device__ __forceinline__ void mid(f32x4 (&acc)[2][2][4][2], const pg8::Unit& u, int wr, int wc, int fr, int fq) const {
        const int row0 = u.pm * 256 + wr * 64 + fr, col0 = u.pn * 256 + wc * 32 + 4 * fq;
#pragma unroll
        for (int ai = 0; ai < 2; ++ai)
#pragma unroll
            for (int m = 0; m < 4; ++m) {
                const unsigned zo = ((unsigned)(row0 + ai * 128 + m * 16) * ZN + col0 + ZC_GA) * 2u;
#pragma unroll
                for (int bj = 0; bj < 2; ++bj)
#pragma unroll
                    for (int n = 0; n < 2; ++n) {
                        const u32x2 ga = *(const u32x2*)((const char*)zb + zo + (bj * 128 + n * 16) * 2), gb = *(const u32x2*)((const char*)zb + zo + (1024 + bj * 128 + n * 16) * 2);
                        f32x4 r;
                        r[0] = (1.0f + __expf(-bflo(gb.x))) * __builtin_amdgcn_rcpf(1.0f + __expf(-bflo(ga.x))); r[1] = (1.0f + __expf(-bfhi(gb.x))) * __builtin_amdgcn_rcpf(1.0f + __expf(-bfhi(ga.x)));
                        r[2] = (1.0f + __expf(-bflo(gb.y))) * __builtin_amdgcn_rcpf(1.0f + __expf(-bflo(ga.y))); r[3] = (1.0f + __expf(-bfhi(gb.y))) * __builtin_amdgcn_rcpf(1.0f + __expf(-bfhi(ga.y)));
                        acc[ai][bj][m][n] *= r;
                    }
                asm volatile("" ::: "memory");
            }
    }
    __device__ __forceinline__ void operator()(const f32x4 (&acc)[2][2][4][2], const pg8::Unit& u, int wr, int wc, int fr, int fq) const {
        const int row0 = u.pm * 256 + wr * 64 + fr, col0 = u.pn * 256 + wc * 32 + 4 * fq;
#pragma unroll
        for (int ai = 0; ai < 2; ++ai)
#pragma unroll
            for (int m = 0; m < 4; ++m) {
                const unsigned ro = (unsigned)(row0 + ai * 128 + m * 16);
                const unsigned zo = (ro * ZN + col0 + ZC_GB) * 2u, mo = (ro * DM + col0) * 2u;
#pragma unroll
                for (int bj = 0; bj < 2; ++bj)
#pragma unroll
                    for (int n = 0; n < 2; ++n) {
                        const u32x2 gb = *(const u32x2*)((const char*)zb + zo + (bj * 128 + n * 16) * 2); const f32x4 v = acc[ai][bj][m][n];
                        u32x2 w; w.x = pk2(v[0] * sigmoidf_(bflo(gb.x)), v[1] * sigmoidf_(bfhi(gb.x))); w.y = pk2(v[2] * sigmoidf_(bflo(gb.y)), v[3] * sigmoidf_(bfhi(gb.y)));
                        *(u32x2*)((char*)mg + mo + (bj * 128 + n * 16) * 2) = w;
                    }
                asm volatile("" ::: "memory");
            }
    }
};
struct FGateA {
    const bf16_t* zb; float* t1;
    __device__ __forceinline__ void operator()(int row, int col, f32x4 v) const {
        const u32x2 g = *(const u32x2*)(zb + (size_t)row * ZN + ZC_GA + col);
        f32x4 o; o[0] = sigmoidf_(bflo(g.x)) * v[0]; o[1] = sigmoidf_(bfhi(g.x)) * v[1]; o[2] = sigmoidf_(bflo(g.y)) * v[2]; o[3] = sigmoidf_(bfhi(g.y)) * v[3];
        *(f32x4*)(t1 + (size_t)row * DM + col) = o;
    }
};
struct FGateB {
    const bf16_t* zb; const float* t1; bf16_t* mg;
    __device__ __forceinline__ void operator()(int row, int col, f32x4 v) const {
        const u32x2 g = *(const u32x2*)(zb + (size_t)row * ZN + ZC_GB + col);
        const f32x4 t = *(const f32x4*)(t1 + (size_t)row * DM + col);
        u32x2 w; w.x = pk2(t[0] + sigmoidf_(bflo(g.x)) * v[0], t[1] + sigmoidf_(bfhi(g.x)) * v[1]); w.y = pk2(t[2] + sigmoidf_(bflo(g.y)) * v[2], t[3] + sigmoidf_(bfhi(g.y)) * v[3]);
        *(u32x2*)(mg + (size_t)row * DM + col) = w;
    }
};
struct FResid {
    const float* xf; float* h;
    __device__ __forceinline__ void operator()(int row, int col, f32x4 v) const {
        const unsigned o = ((unsigned)row * DM + col) * 4u;
        const f32x4 x = *(const f32x4*)((const char*)xf + o);
        *(f32x4*)((char*)h + o) = x * ALPHA + v;
    }
};
struct EpiUp {
    static constexpr bool PERM = true, AFTER_DRAIN = false; static constexpr int MID_T = 0;
    bf16_t* up; float* outp; float* outs;
    __device__ __forceinline__ void operator()(const f32x4 (&acc)[2][2][4][2], const pg8::Unit& u, int wr, int wc, int fr, int fq) const {
        const int row0 = u.pm * 256 + wr * 64 + fr, col0 = u.pn * 256 + wc * 32 + 8 * fq;
#pragma unroll
        for (int ai = 0; ai < 2; ++ai)
#pragma unroll
            for (int m = 0; m < 4; ++m) {
                const int row = row0 + ai * 128 + m * 16;
                float* fo = nullptr;
                if (row < TP) { const int pos = row & (SEQ - 1); if (pos >= SEQ - 2) fo = outp + ((size_t)(row >> 11) * 2 + (pos - (SEQ - 2))) * DUP; }
                else if (row < MT) fo = outs + ((size_t)(row - TP) * 2 + 1) * DUP;
#pragma unroll
                for (int bj = 0; bj < 2; ++bj) {
                    const f32x4 v0 = acc[ai][bj][m][0], v1 = acc[ai][bj][m][1];
                    u32x4v w; w.x = pk2(v0[0], v0[1]); w.y = pk2(v0[2], v0[3]); w.z = pk2(v1[0], v1[1]); w.w = pk2(v1[2], v1[3]);
                    *(u32x4v*)(up + (size_t)row * DUP + col0 + bj * 128) = w;
                    if (fo) { *(f32x4*)(fo + col0 + bj * 128) = v0; *(f32x4*)(fo + col0 + bj * 128 + 4) = v1; }
                }
            }
    }
};

template <class F>
__device__ void micro_gemm(LAS unsigned char* lds, const bf16_t* A, int lda, const bf16_t* Bt, int ldb, int K, const F& f) {
    int tid_ = threadIdx.x; asm volatile("" : "+v"(tid_)); const int tid = tid_, wid = __builtin_amdgcn_readfirstlane(tid >> 6), lane = tid & 63, g = lane >> 4, lr = lane & 15;
    LAS f32x4* red = (LAS f32x4*)lds;
    for (int id = blockIdx.x; id < 256; id += gridDim.x) {
        const int mb = id >> 6, nb = id & 63, ks = K >> 3, kb = wid * ks;
        const bf16_t* a0 = A + (size_t)(TP + mb * 32 + lr) * lda + kb + 8 * g; const bf16_t* a1 = a0 + (size_t)16 * lda;
        const bf16_t* b0 = Bt + (size_t)(nb * 16 + lr) * ldb + kb + 8 * g;
        f32x4 c0 = {0.f, 0.f, 0.f, 0.f}, c1 = {0.f, 0.f, 0.f, 0.f};
        for (int k = 0; k < ks; k += 32) {
            const bf16x8 fa0 = *(const bf16x8*)(a0 + k), fa1 = *(const bf16x8*)(a1 + k), fb = *(const bf16x8*)(b0 + k);
            c0 = mfma16(fb, fa0, c0); c1 = mfma16(fb, fa1, c1);
        }
        red[(wid * 2 + 0) * 64 + lane] = c0; red[(wid * 2 + 1) * 64 + lane] = c1;
        bar();
        if (wid < 2) {
            f32x4 s = {0.f, 0.f, 0.f, 0.f};
#pragma unroll
            for (int w = 0; w < 8; ++w) s += red[(w * 2 + wid) * 64 + lane];
            f(TP + mb * 32 + wid * 16 + lr, nb * 16 + 4 * g, s);
        }
        bar();
    }
}

__device__ void mlstm_pass1(KP P, int l, LAS unsigned char* lds) {
    int tid_ = threadIdx.x; asm volatile("" : "+v"(tid_)); const int tid = tid_, wid = __builtin_amdgcn_readfirstlane(tid >> 6), lane = tid & 63, g = lane >> 4, lr = lane & 15;
    constexpr int KST = 544, VST = 96, OFF_V = 128 * KST, OFF_G = OFF_V + 128 * VST;
    LAS unsigned char* Kimg = lds; LAS unsigned char* Vimg = lds + OFF_V;
    LAS float* garr = (LAS float*)(lds + OFF_G);
    LAS float* nred = garr + 2 * 400;
    const bf16_t* zb = (const bf16_t*)(P->ws + WS_ZB); const float* gt = (const float*)(P->ws + WS_GT); float* gtab = (float*)(P->ws + WS_GTAB);
    bf16_t* CSt = (bf16_t*)(P->ws + WS_CST); float* NSt = (float*)(P->ws + WS_NST);
    for (int item = blockIdx.x; item < 256; item += gridDim.x) {
        const int bh = item >> 3, j = item & 7, b = bh >> 2, h = bh & 3;
        const size_t row0 = (size_t)b * SEQ;
        const float bi = P->in[8][l * 4 + h], bfg = P->in[9][l * 4 + h];
        f32x4 acc[2][2];
#pragma unroll
        for (int a = 0; a < 2; ++a)
#pragma unroll
            for (int c = 0; c < 2; ++c) acc[a][c] = (f32x4){0.f, 0.f, 0.f, 0.f};
        float nreg = 0.f, m_c = 0.f;
        u32x4v kreg[8]; u32x4v vreg; float gi0 = 0.f, gf0 = 0.f, gi1 = 0.f, gf1 = 0.f;
        {
            const size_t r0 = row0;
#pragma unroll
            for (int i = 0; i < 8; ++i) { const int vec = tid + 512 * i, row = vec >> 5, cv = vec & 31; kreg[i] = *(const u32x4v*)(zb + (r0 + row) * ZN + ZC_K + h * 256 + cv * 8); }
            { const int row = tid >> 2, cv = tid & 3; vreg = *(const u32x4v*)(zb + (r0 + row) * ZN + ZC_V + h * 256 + 32 * j + cv * 8); }
            if (wid == 0) { const float* gp = gt + (r0 + 2 * lane) * 8; gi0 = gp[h]; gf0 = gp[4 + h]; gi1 = gp[8 + h]; gf1 = gp[12 + h]; }
        }
        for (int c = 0; c < 16; ++c) {
            const size_t r0 = row0 + (size_t)c * 128;
            LAS float* ga = garr + (c & 1) * 400; LAS float* gM = ga + 128; LAS float* gw = ga + 256; LAS float* misc = ga + 384;
            if (wid == 0) {
                const float li0 = gi0 + bi, li1 = gi1 + bi, lf0 = logsigmoidf_(gf0 + bfg), lf1 = logsigmoidf_(gf1 + bfg);
                float sc = lf0 + lf1;
#pragma unroll
                for (int o = 1; o < 64; o <<= 1) { const float t = __shfl_up(sc, o); if (lane >= o) sc += t; }
                const float b1 = sc, b0 = sc - lf1;
                const float a0 = li0 - b0, a1 = li1 - b1;
                float sm = fmaxf(a0, a1);
#pragma unroll
                for (int o = 1; o < 64; o <<= 1) { const float t = __shfl_up(sm, o); if (lane >= o) sm = fmaxf(sm, t); }
                float ex = __shfl_up(sm, 1); if (lane == 0) ex = -INFINITY;
                const float M0 = fmaxf(m_c, fmaxf(ex, a0)), M1 = fmaxf(m_c, sm);
                const float blast = __shfl(b1, 63), Mlast = __shfl(M1, 63);
                ga[2 * lane] = a0; ga[2 * lane + 1] = a1; gM[2 * lane] = M0; gM[2 * lane + 1] = M1;
                gw[2 * lane] = __expf(a0 - Mlast); gw[2 * lane + 1] = __expf(a1 - Mlast);
                if (lane == 0) { misc[0] = __expf(m_c - Mlast); misc[1] = Mlast; }
                if (j == 0) {
                    *(float4*)(gtab + ((r0 + 2 * lane) * 4 + h) * 4) = make_float4(a0, M0, __expf(m_c - M0), __expf(-(b0 + M0)));
                    *(float4*)(gtab + ((r0 + 2 * lane + 1) * 4 + h) * 4) = make_float4(a1, M1, __expf(m_c - M1), __expf(-(b1 + M1)));
                }
                m_c = blast + Mlast;
            }
            {
                bf16_t* cs = CSt + ((size_t)(bh * 16 + c) << 16);
#pragma unroll
                for (int kt = 0; kt < 2; ++kt)
#pragma unroll
                    for (int vt = 0; vt < 2; ++vt) {
                        const int v = 32 * j + 16 * vt + lr, k = 32 * wid + 16 * kt + 4 * g;
                        u32x2 w; w.x = pk2(acc[kt][vt][0], acc[kt][vt][1]); w.y = pk2(acc[kt][vt][2], acc[kt][vt][3]);
                        *(u32x2*)(cs + v * 256 + k) = w;
                    }
                if (j == 0 && tid < 256) NSt[(size_t)(bh * 16 + c) * 256 + tid] = nreg;
            }
            bar();
            const float decay = misc[0];
#pragma unroll
            for (int i = 0; i < 8; ++i) { const int vec = tid + 512 * i, row = vec >> 5, cv = vec & 31; *(LAS u32x4v*)(Kimg + row * KST + cv * 16) = kreg[i]; }
            {
                const int row = tid >> 2, cv = tid & 3; const float w = gw[row];
                u32x4v o; o.x = pk2(bflo(vreg.x) * w, bfhi(vreg.x) * w); o.y = pk2(bflo(vreg.y) * w, bfhi(vreg.y) * w); o.z = pk2(bflo(vreg.z) * w, bfhi(vreg.z) * w); o.w = pk2(bflo(vreg.w) * w, bfhi(vreg.w) * w);
                *(LAS u32x4v*)(Vimg + row * VST + cv * 16) = o;
            }
            if (c + 1 < 16) {
                const size_t r1 = r0 + 128;
#pragma unroll
                for (int i = 0; i < 8; ++i) { const int vec = tid + 512 * i, row = vec >> 5, cv = vec & 31; kreg[i] = *(const u32x4v*)(zb + (r1 + row) * ZN + ZC_K + h * 256 + cv * 8); }
                { const int row = tid >> 2, cv = tid & 3; vreg = *(const u32x4v*)(zb + (r1 + row) * ZN + ZC_V + h * 256 + 32 * j + cv * 8); }
                if (wid == 0) { const float* gp = gt + (r1 + 2 * lane) * 8; gi0 = gp[h]; gf0 = gp[4 + h]; gi1 = gp[8 + h]; gf1 = gp[12 + h]; }
            }
            bar();
#pragma unroll
            for (int kt = 0; kt < 2; ++kt)
#pragma unroll
                for (int vt = 0; vt < 2; ++vt) acc[kt][vt] *= decay;
#pragma unroll
            for (int ss = 0; ss < 4; ++ss) {
                const int sr = 32 * ss + 4 * g + (lr >> 2);
                bf16x8 fa[2], fb[2];
#pragma unroll
                for (int kt = 0; kt < 2; ++kt) {
                    const LAS unsigned char* p = Kimg + sr * KST + (32 * wid + 16 * kt + 4 * (lr & 3)) * 2;
                    fa[kt] = cat8(tr_read(p), tr_read(p + 16 * KST));
                }
#pragma unroll
                for (int vt = 0; vt < 2; ++vt) {
                    const LAS unsigned char* p = Vimg + sr * VST + (16 * vt + 4 * (lr & 3)) * 2;
                    fb[vt] = cat8(tr_read(p), tr_read(p + 16 * VST));
                }
#pragma unroll
                for (int kt = 0; kt < 2; ++kt)
#pragma unroll
                    for (int vt = 0; vt < 2; ++vt) acc[kt][vt] = mfma16(fa[kt], fb[vt], acc[kt][vt]);
            }
            {
                const int k = tid & 255, hs = tid >> 8; float s = 0.f;
                for (int si = 0; si < 64; ++si) { const int sidx = hs * 64 + si; s += gw[sidx] * bf2f(*(const LAS unsigned short*)(Kimg + sidx * KST + k * 2)); }
                nred[hs * 256 + k] = s;
            }
            bar();
            if (tid < 256) nreg = decay * nreg + nred[tid] + nred[256 + tid];
        }
        {
            float* Co = P->out + O_CP + ((size_t)((l * NBATCH + b) * HM + h) << 16);
#pragma unroll
            for (int kt = 0; kt < 2; ++kt)
#pragma unroll
                for (int vt = 0; vt < 2; ++vt)
#pragma unroll
                    for (int e = 0; e < 4; ++e) Co[(size_t)(32 * wid + 16 * kt + 4 * g + e) * 256 + 32 * j + 16 * vt + lr] = acc[kt][vt][e];
            if (j == 0 && tid < 256) P->out[O_NP + (size_t)((l * NBATCH + b) * HM + h) * 256 + tid] = nreg;
            if (j == 0 && tid == 0) P->out[O_MP + (l * NBATCH + b) * HM + h] = m_c;
        }
        bar();
    }
}

__device__ void mlstm_sample(KP P, int l, LAS unsigned char* lds) {
    int tid_ = threadIdx.x; asm volatile("" : "+v"(tid_)); const int tid = tid_, wid = __builtin_amdgcn_readfirstlane(tid >> 6), lane = tid & 63;
    LAS float* sq = (LAS float*)lds; LAS float* sk = sq + 256; LAS float* sv = sk + 256; LAS float* sn0 = sv + 256; LAS float* sred = sn0 + 256; LAS float* red = sred + 64;
    const bf16_t* zb = (const bf16_t*)(P->ws + WS_ZB); const float* gt = (const float*)(P->ws + WS_GT); bf16_t* AB = (bf16_t*)(P->ws + WS_AB);
    for (int item = blockIdx.x; item < NSMP * HM; item += gridDim.x) {
        const int b = item >> 2, h = item & 3; const size_t row = TP + b; const size_t sidx = (size_t)(l * NSMP + b) * HM + h;
        if (tid < 256) {
            sq[tid] = bf2f(zb[row * ZN + ZC_Q + h * 256 + tid]); sk[tid] = bf2f(zb[row * ZN + ZC_K + h * 256 + tid]); sv[tid] = bf2f(zb[row * ZN + ZC_V + h * 256 + tid]);
            sn0[tid] = P->in[4][sidx * 256 + tid];
        }
        bar();
        const float li = gt[row * 8 + h] + P->in[8][l * 4 + h], lf = logsigmoidf_(gt[row * 8 + 4 + h] + P->in[9][l * 4 + h]), m0 = P->in[5][sidx];
        const float m_t = fmaxf(lf + m0, li), sc = expf(lf + m0 - m_t), wi = expf(li - m_t);
        float pqk = 0.f, pqn = 0.f;
        if (tid < 256) { pqk = sq[tid] * sk[tid]; pqn = sq[tid] * sn0[tid]; }
        pqk = wsum(pqk); pqn = wsum(pqn);
        if (lane == 0) { sred[wid] = pqk; sred[8 + wid] = pqn; }
        const float* C0 = P->in[3] + (sidx << 16); float* C1 = P->out + O_CS + (sidx << 16);
        float4 qc = make_float4(0.f, 0.f, 0.f, 0.f); const f32x4 vv_ = *(const LAS f32x4*)(sv + 4 * lane); const float4 vv = make_float4(vv_[0], vv_[1], vv_[2], vv_[3]);
#pragma unroll 8
        for (int i = 0; i < 32; ++i) {
            const int k = wid + 8 * i; const float4 cv = *(const float4*)(C0 + k * 256 + 4 * lane); const float qk_ = sq[k], kw = wi * sk[k];
            qc.x += qk_ * cv.x; qc.y += qk_ * cv.y; qc.z += qk_ * cv.z; qc.w += qk_ * cv.w;
            *(float4*)(C1 + k * 256 + 4 * lane) = make_float4(sc * cv.x + kw * vv.x, sc * cv.y + kw * vv.y, sc * cv.z + kw * vv.z, sc * cv.w + kw * vv.w);
        }
        *(LAS f32x4*)(red + wid * 256 + 4 * lane) = (f32x4){qc.x, qc.y, qc.z, qc.w};
        bar();
        float qk = 0.f, qn = 0.f;
#pragma unroll
        for (int w = 0; w < 4; ++w) { qk += sred[w]; qn += sred[8 + w]; }
        float hcv = 0.f;
        if (tid < 256) {
            float qC = 0.f;
#pragma unroll
            for (int w = 0; w < 8; ++w) qC += red[w * 256 + tid];
            const float s = qk * wi, numer = s * sv[tid] + sc * qC, den = s + sc * qn;
            hcv = numer / fmaxf(fabsf(den), expf(-m_t));
            P->out[O_NS + sidx * 256 + tid] = sc * sn0[tid] + wi * sk[tid];
        }
        if (tid == 0) P->out[O_MS + sidx] = m_t;
        float s1 = wsum(hcv);
        bar();
        if (lane == 0) sred[wid] = s1;
        bar();
        const float mu = (sred[0] + sred[1] + sred[2] + sred[3]) * (1.0f / 256.0f);
        const float dv = (tid < 256) ? hcv - mu : 0.f;
        float s2 = wsum(dv * dv);
        bar();
        if (lane == 0) sred[wid] = s2;
        bar();
        const float rstd = rsqrtf((sred[0] + sred[1] + sred[2] + sred[3]) * (1.0f / 256.0f) + LN_EPS);
        if (tid < 256) {
            const float og = bf2f(zb[row * ZN + ZC_O + h * 256 + tid]);
            AB[row * KPR + 512 + h * 256 + tid] = f2bf(sigmoidf_(og) * (dv * rstd * P->in[11][l * DM + h * 256 + tid]));
        }
        bar();
    }
}

__device__ __forceinline__ void unpack8(const u32x4v w, float (&o)[8]) { o[0] = bflo(w.x); o[1] = bfhi(w.x); o[2] = bflo(w.y); o[3] = bfhi(w.y); o[4] = bflo(w.z); o[5] = bfhi(w.z); o[6] = bflo(w.w); o[7] = bfhi(w.w); }
__device__ __forceinline__ void ld8f(const float* p, float (&o)[8]) { const float4 a = *(const float4*)p, b = *(const float4*)(p + 4); o[0] = a.x; o[1] = a.y; o[2] = a.z; o[3] = a.w; o[4] = b.x; o[5] = b.y; o[6] = b.z; o[7] = b.w; }
__device__ __forceinline__ void st8f(float* p, const float (&o)[8]) { *(float4*)p = make_float4(o[0], o[1], o[2], o[3]); *(float4*)(p + 4) = make_float4(o[4], o[5], o[6], o[7]); }
__device__ __forceinline__ u32x4v pack8(const float (&o)[8]) { u32x4v w; w.x = pk2(o[0], o[1]); w.y = pk2(o[2], o[3]); w.z = pk2(o[4], o[5]); w.w = pk2(o[6], o[7]); return w; }

__device__ void conv_branch(KP P, int l) {
    int tid_ = threadIdx.x; asm volatile("" : "+v"(tid_)); const int tid = tid_;
    const bf16_t* zb = (const bf16_t*)(P->ws + WS_ZB); bf16_t* AB = (bf16_t*)(P->ws + WS_AB);
    const float* wc = P->in[10] + (size_t)l * 3 * DCONV;
    for (int task = blockIdx.x * 512 + tid; task < (TP / 8) * 64 + NSMP * 64; task += gridDim.x * 512) {
        if (task < (TP / 8) * 64) {
            const int cv = task & 63, tg = task >> 6; const size_t t0 = (size_t)tg * 8; const int pos0 = (int)(t0 & (SEQ - 1)), b = (int)(t0 >> 11);
            float w0[8], w1[8], w2[8], pm2[8], pm1[8];
            ld8f(wc + cv * 8, w0); ld8f(wc + DCONV + cv * 8, w1); ld8f(wc + 2 * DCONV + cv * 8, w2);
            if (pos0 == 0) {
#pragma unroll
                for (int e = 0; e < 8; ++e) { pm2[e] = 0.f; pm1[e] = 0.f; }
            } else {
                float c_[8], x_[8];
                unpack8(*(const u32x4v*)(zb + (t0 - 2) * ZN + ZC_CG + cv * 8), c_); unpack8(*(const u32x4v*)(zb + (t0 - 2) * ZN + ZC_XV + cv * 8), x_);
#pragma unroll
                for (int e = 0; e < 8; ++e) pm2[e] = c_[e] * x_[e];
                unpack8(*(const u32x4v*)(zb + (t0 - 1) * ZN + ZC_CG + cv * 8), c_); unpack8(*(const u32x4v*)(zb + (t0 - 1) * ZN + ZC_XV + cv * 8), x_);
#pragma unroll
                for (int e = 0; e < 8; ++e) pm1[e] = c_[e] * x_[e];
            }
#pragma unroll
            for (int r = 0; r < 8; ++r) {
                const size_t row = t0 + r; float c_[8], x_[8], g_[8], o_[8], p_[8];
                unpack8(*(const u32x4v*)(zb + row * ZN + ZC_CG + cv * 8), c_); unpack8(*(const u32x4v*)(zb + row * ZN + ZC_XV + cv * 8), x_); unpack8(*(const u32x4v*)(zb + row * ZN + ZC_BG + cv * 8), g_);
#pragma unroll
                for (int e = 0; e < 8; ++e) { p_[e] = c_[e] * x_[e]; o_[e] = g_[e] * (w0[e] * pm2[e] + w1[e] * pm1[e] + w2[e] * p_[e]); pm2[e] = pm1[e]; pm1[e] = p_[e]; }
                *(u32x4v*)(AB + row * KPR + cv * 8) = pack8(o_);
                if (pos0 + r >= SEQ - 2) st8f(P->out + O_SCP + ((size_t)(l * NBATCH + b) * 2 + (pos0 + r - (SEQ - 2))) * DCONV + cv * 8, p_);
            }
        } else {
            const int t2 = task - (TP / 8) * 64, cv = t2 & 63, b = t2 >> 6; const size_t row = TP + b;
            float w0[8], w1[8], w2[8], pm2[8], pm1[8], c_[8], x_[8], g_[8], o_[8], p_[8];
            ld8f(wc + cv * 8, w0); ld8f(wc + DCONV + cv * 8, w1); ld8f(wc + 2 * DCONV + cv * 8, w2);
            const float* cache = P->in[2] + ((size_t)(l * NSMP + b) * 2) * DCONV + cv * 8;
            ld8f(cache, pm2); ld8f(cache + DCONV, pm1);
            unpack8(*(const u32x4v*)(zb + row * ZN + ZC_CG + cv * 8), c_); unpack8(*(const u32x4v*)(zb + row * ZN + ZC_XV + cv * 8), x_); unpack8(*(const u32x4v*)(zb + row * ZN + ZC_BG + cv * 8), g_);
#pragma unroll
            for (int e = 0; e < 8; ++e) { p_[e] = c_[e] * x_[e]; o_[e] = g_[e] * (w0[e] * pm2[e] + w1[e] * pm1[e] + w2[e] * p_[e]); }
            *(u32x4v*)(AB + row * KPR + cv * 8) = pack8(o_);
            float* so = P->out + O_SCS + ((size_t)(l * NSMP + b) * 2) * DCONV + cv * 8;
            st8f(so, pm1); st8f(so + DCONV, p_);
        }
    }
}

__device__ void mlstm_pass2(KP P, int l, LAS unsigned char* lds) {
    int tid_ = threadIdx.x; asm volatile("" : "+v"(tid_)); const int tid = tid_, wid = __builtin_amdgcn_readfirstlane(tid >> 6), lane = tid & 63, g = lane >> 4, lr = lane & 15;
    constexpr int CST = 528, KST = 528, VST = 544, OFF_V = 128 * KST, OFF_A = 137216;
    LAS float* sa = (LAS float*)(lds + OFF_A); LAS float* sM = sa + 128; LAS float* ssc = sM + 128; LAS float* sfl = ssc + 128; LAS float* sn = sfl + 128;
    const bf16_t* zb = (const bf16_t*)(P->ws + WS_ZB); const float* gtab = (const float*)(P->ws + WS_GTAB); bf16_t* AB = (bf16_t*)(P->ws + WS_AB);
    const bf16_t* CSt = (const bf16_t*)(P->ws + WS_CST); const float* NSt = (const float*)(P->ws + WS_NST);
    for (int item = blockIdx.x; item < 512; item += gridDim.x) {
        const int bh = item >> 4, c = item & 15, b = bh >> 2, h = bh & 3;
        const size_t r0 = (size_t)b * SEQ + (size_t)c * 128;
        {
            const bf16_t* cs = CSt + ((size_t)(bh * 16 + c) << 16);
#pragma unroll
            for (int hb_ = 0; hb_ < 2; ++hb_) {
                u32x4v t[8];
#pragma unroll
                for (int i = 0; i < 8; ++i) t[i] = *(const u32x4v*)((const char*)cs + (unsigned)(tid + 512 * (hb_ * 8 + i)) * 16u);
#pragma unroll
                for (int i = 0; i < 8; ++i) { const int vec = tid + 512 * (hb_ * 8 + i), row = vec >> 5, cv = vec & 31; *(LAS u32x4v*)(lds + row * CST + cv * 16) = t[i]; }
                asm volatile("" ::: "memory");
            }
            if (tid < 128) { const float4 t = *(const float4*)(gtab + ((r0 + tid) * 4 + h) * 4); sa[tid] = t.x; sM[tid] = t.y; ssc[tid] = t.z; sfl[tid] = t.w; }
            if (tid < 256) sn[tid] = NSt[(size_t)(bh * 16 + c) * 256 + tid];
        }
        bf16x8 Qf[8];
        {
            const bf16_t* qp = zb + (r0 + 16 * wid + lr) * ZN + ZC_Q + h * 256 + 8 * g;
#pragma unroll
            for (int ks = 0; ks < 8; ++ks) Qf[ks] = *(const bf16x8*)(qp + 32 * ks);
        }
        bar();
        f32x4 acc[16];
#pragma unroll
        for (int vt = 0; vt < 16; ++vt) acc[vt] = (f32x4){0.f, 0.f, 0.f, 0.f};
#pragma unroll
        for (int vt = 0; vt < 16; ++vt)
#pragma unroll
            for (int ks = 0; ks < 8; ++ks) {
                const bf16x8 fa = *(const LAS bf16x8*)(lds + (16 * vt + lr) * CST + (32 * ks + 8 * g) * 2);
                acc[vt] = mfma16(fa, Qf[ks], acc[vt]);
            }
        float qn = 0.f;
#pragma unroll
        for (int ks = 0; ks < 8; ++ks)
#pragma unroll
            for (int e = 0; e < 8; ++e) qn += bf2f((unsigned short)Qf[ks][e]) * sn[32 * ks + 8 * g + e];
        qn += __shfl_xor(qn, 16); qn += __shfl_xor(qn, 32);
        const int tl = 16 * wid + lr;
        const float sc_t = ssc[tl], M_t = sM[tl], fl_t = sfl[tl];
#pragma unroll
        for (int vt = 0; vt < 16; ++vt) acc[vt] *= sc_t;
        bar();
        {
            const unsigned kb0 = (unsigned)(((tid >> 5)) * ZN + ZC_K + h * 256 + (tid & 31) * 8) * 2u;
            const char* zr = (const char*)(zb + r0 * ZN);
#pragma unroll
            for (int hb_ = 0; hb_ < 2; ++hb_) {
                u32x4v t[4], u[4];
#pragma unroll
                for (int i = 0; i < 4; ++i) { t[i] = *(const u32x4v*)(zr + kb0 + (unsigned)((hb_ * 4 + i) * 16 * ZN * 2)); u[i] = *(const u32x4v*)(zr + kb0 + (unsigned)((hb_ * 4 + i) * 16 * ZN * 2 + (ZC_V - ZC_K) * 2)); }
#pragma unroll
                for (int i = 0; i < 4; ++i) { const int row = (tid >> 5) + (hb_ * 4 + i) * 16, cv = tid & 31; *(LAS u32x4v*)(lds + row * KST + cv * 16) = t[i]; *(LAS u32x4v*)(lds + OFF_V + row * VST + cv * 16) = u[i]; }
                asm volatile("" ::: "memory");
            }
        }
        bar();
        float rs = 0.f;
#pragma unroll
        for (int pp = 0; pp < 4; ++pp) {
            if (2 * pp <= wid) {
                f32x4 s0 = {0.f, 0.f, 0.f, 0.f}, s1 = {0.f, 0.f, 0.f, 0.f};
                const bool two = (2 * pp + 1 <= wid);
#pragma unroll
                for (int ks = 0; ks < 8; ++ks) {
                    const bf16x8 k0 = *(const LAS bf16x8*)(lds + (32 * pp + lr) * KST + (32 * ks + 8 * g) * 2);
                    s0 = mfma16(k0, Qf[ks], s0);
                    if (two) { const bf16x8 k1 = *(const LAS bf16x8*)(lds + (32 * pp + 16 + lr) * KST + (32 * ks + 8 * g) * 2); s1 = mfma16(k1, Qf[ks], s1); }
                }
                const f32x4 a0 = *(const LAS f32x4*)(sa + 32 * pp + 4 * g), a1 = *(const LAS f32x4*)(sa + 32 * pp + 16 + 4 * g);
                float p0[4], p1[4];
#pragma unroll
                for (int e = 0; e < 4; ++e) {
                    const int sA = 32 * pp + 4 * g + e, sB = sA + 16;
                    p0[e] = (sA <= tl) ? s0[e] * __expf(a0[e] - M_t) : 0.f;
                    p1[e] = (sB <= tl) ? s1[e] * __expf(a1[e] - M_t) : 0.f;
                    rs += p0[e] + p1[e];
                }
                bf16x8 Pf;
                {
                    const unsigned w0 = pk2(p0[0], p0[1]), w1 = pk2(p0[2], p0[3]), w2 = pk2(p1[0], p1[1]), w3 = pk2(p1[2], p1[3]);
                    Pf[0] = (short)(w0 & 0xffff); Pf[1] = (short)(w0 >> 16); Pf[2] = (short)(w1 & 0xffff); Pf[3] = (short)(w1 >> 16);
                    Pf[4] = (short)(w2 & 0xffff); Pf[5] = (short)(w2 >> 16); Pf[6] = (short)(w3 & 0xffff); Pf[7] = (short)(w3 >> 16);
                }
                const LAS unsigned char* vb = lds + OFF_V + (32 * pp + 4 * g + (lr >> 2)) * VST + (4 * (lr & 3)) * 2;
#pragma unroll
                for (int vt = 0; vt < 16; ++vt) {
                    const bf16x8 fv = cat8(tr_read(vb + vt * 32), tr_read(vb + vt * 32 + 16 * VST));
                    acc[vt] = mfma16(fv, Pf, acc[vt]);
                }
            }
        }
        rs += __shfl_xor(rs, 16); rs += __shfl_xor(rs, 32);
        const float den = rs + sc_t * qn, inv = 1.0f / fmaxf(fabsf(den), fl_t);
        float s1 = 0.f;
#pragma unroll
        for (int vt = 0; vt < 16; ++vt) { acc[vt] *= inv; s1 += (acc[vt][0] + acc[vt][1]) + (acc[vt][2] + acc[vt][3]); }
        s1 += __shfl_xor(s1, 16); s1 += __shfl_xor(s1, 32);
        const float mu = s1 * (1.0f / 256.0f);
        float s2 = 0.f;
#pragma unroll
        for (int vt = 0; vt < 16; ++vt) { acc[vt] -= mu; s2 += (acc[vt][0] * acc[vt][0] + acc[vt][1] * acc[vt][1]) + (acc[vt][2] * acc[vt][2] + acc[vt][3] * acc[vt][3]); }
        s2 += __shfl_xor(s2, 16); s2 += __shfl_xor(s2, 32);
        const float rstd = rsqrtf(s2 * (1.0f / 256.0f) + LN_EPS);
        {
            const size_t row = r0 + tl; const float* mg_ = P->in[11] + l * DM + h * 256;
#pragma unroll
            for (int vt = 0; vt < 16; ++vt) {
                const int v0 = 16 * vt + 4 * g;
                const float4 gm = *(const float4*)(mg_ + v0); const u32x2 og = *(const u32x2*)(zb + row * ZN + ZC_O + h * 256 + v0);
                u32x2 w;
                w.x = pk2(sigmoidf_(bflo(og.x)) * (acc[vt][0] * rstd * gm.x), sigmoidf_(bfhi(og.x)) * (acc[vt][1] * rstd * gm.y));
                w.y = pk2(sigmoidf_(bflo(og.y)) * (acc[vt][2] * rstd * gm.z), sigmoidf_(bfhi(og.y)) * (acc[vt][3] * rstd * gm.w));
                *(u32x2*)(AB + row * KPR + 512 + h * 256 + v0) = w;
            }
        }
        bar();
    }
}

__device__ void conv_act(KP P, int l) {
    int tid_ = threadIdx.x; asm volatile("" : "+v"(tid_)); const int tid = tid_;
    const bf16_t* up = (const bf16_t*)(P->ws + WS_UP); bf16_t* act = (bf16_t*)(P->ws + WS_ACT);
    const float* wc = P->in[18] + (size_t)l * 3 * DUP;
    constexpr int NCV = DFF / 8;
    constexpr int NT_P = (TP / 8) * NCV, NT_S = NSMP * NCV;
    for (int task = blockIdx.x * 512 + tid; task < NT_P + NT_S; task += gridDim.x * 512) {
        if (task < NT_P) {
            const int cv = task % NCV, tg = task / NCV; const size_t t0 = (size_t)tg * 8; const int pos0 = (int)(t0 & (SEQ - 1));
            float wg0[8], wg1[8], wg2[8], wu0[8], wu1[8], wu2[8], g2[8], g1[8], u2[8], u1[8];
            ld8f(wc + cv * 8, wg0); ld8f(wc + DUP + cv * 8, wg1); ld8f(wc + 2 * DUP + cv * 8, wg2);
            ld8f(wc + DFF + cv * 8, wu0); ld8f(wc + DUP + DFF + cv * 8, wu1); ld8f(wc + 2 * DUP + DFF + cv * 8, wu2);
            if (pos0 == 0) {
#pragma unroll
                for (int e = 0; e < 8; ++e) { g2[e] = 0.f; g1[e] = 0.f; u2[e] = 0.f; u1[e] = 0.f; }
            } else {
                unpack8(*(const u32x4v*)(up + (t0 - 2) * DUP + cv * 8), g2); unpack8(*(const u32x4v*)(up + (t0 - 1) * DUP + cv * 8), g1);
                unpack8(*(const u32x4v*)(up + (t0 - 2) * DUP + DFF + cv * 8), u2); unpack8(*(const u32x4v*)(up + (t0 - 1) * DUP + DFF + cv * 8), u1);
            }
#pragma unroll
            for (int r = 0; r < 8; ++r) {
                const size_t row = t0 + r; float g0[8], u0[8], o_[8];
                unpack8(*(const u32x4v*)(up + row * DUP + cv * 8), g0); unpack8(*(const u32x4v*)(up + row * DUP + DFF + cv * 8), u0);
#pragma unroll
                for (int e = 0; e < 8; ++e) {
                    const float gc = wg0[e] * g2[e] + wg1[e] * g1[e] + wg2[e] * g0[e], uc = wu0[e] * u2[e] + wu1[e] * u1[e] + wu2[e] * u0[e];
                    o_[e] = gc * sigmoidf_(gc) * uc; g2[e] = g1[e]; g1[e] = g0[e]; u2[e] = u1[e]; u1[e] = u0[e];
                }
                *(u32x4v*)(act + row * DFF + cv * 8) = pack8(o_);
            }
        } else {
            const int t2 = task - NT_P, cv = t2 % NCV, b = t2 / NCV; const size_t row = TP + b;
            float wg0[8], wg1[8], wg2[8], wu0[8], wu1[8], wu2[8], g2[8], g1[8], u2[8], u1[8], g0[8], u0[8], o_[8];
            ld8f(wc + cv * 8, wg0); ld8f(wc + DUP + cv * 8, wg1); ld8f(wc + 2 * DUP + cv * 8, wg2);
            ld8f(wc + DFF + cv * 8, wu0); ld8f(wc + DUP + DFF + cv * 8, wu1); ld8f(wc + 2 * DUP + DFF + cv * 8, wu2);
            const float* cache = P->in[6] + ((size_t)(l * NSMP + b) * 2) * DUP;
            ld8f(cache + cv * 8, g2); ld8f(cache + DUP + cv * 8, g1); ld8f(cache + DFF + cv * 8, u2); ld8f(cache + DUP + DFF + cv * 8, u1);
            unpack8(*(const u32x4v*)(up + row * DUP + cv * 8), g0); unpack8(*(const u32x4v*)(up + row * DUP + DFF + cv * 8), u0);
#pragma unroll
            for (int e = 0; e < 8; ++e) {
                const float gc = wg0[e] * g2[e] + wg1[e] * g1[e] + wg2[e] * g0[e], uc = wu0[e] * u2[e] + wu1[e] * u1[e] + wu2[e] * u0[e];
                o_[e] = gc * sigmoidf_(gc) * uc;
            }
            *(u32x4v*)(act + row * DFF + cv * 8) = pack8(o_);
            float* fo = P->out + O_FS + ((size_t)(l * NSMP + b) * 2) * DUP;
            st8f(fo + cv * 8, g1); st8f(fo + DFF + cv * 8, u1);
        }
    }
}


#define XB_TMO      128
#define XB_XCNT(j)  (256  + 64 * (j))
#define XB_XSUB(j)  (1280 + 64 * (j))
#define XB_XGEN(j)  (2304 + 64 * (j))
#define XB_TOP      3328
#define XB_TOPGEN   3392
#define XCD_BAR_WORDS 3456
#define XB_SPIN_CAP (1u << 18)
__device__ __forceinline__ unsigned xb_ld(unsigned* p)              { return __hip_atomic_load(p, __ATOMIC_RELAXED, __HIP_MEMORY_SCOPE_AGENT); }
__device__ __forceinline__ unsigned xb_add(unsigned* p, unsigned v) { return __hip_atomic_fetch_add(p, v, __ATOMIC_RELAXED, __HIP_MEMORY_SCOPE_AGENT); }
__device__ __forceinline__ unsigned xb_xcc_id() { return (unsigned)__builtin_amdgcn_s_getreg((3 << 11) | 20) & 0xFu; }
#define XB_SPIN(cond, bar) do { unsigned _sp = 0; while (cond) { __builtin_amdgcn_s_sleep(1); \
    if ((++_sp & 255u) == 0u) { if (xb_ld(&(bar)[XB_TMO])) break; if (_sp > XB_SPIN_CAP) { atomicAdd(&(bar)[XB_TMO], 1u); break; } } } } while (0)
struct XcdBarrier { unsigned* bar; unsigned x; volatile LAS unsigned* st; };
__device__ __forceinline__ XcdBarrier xcd_barrier_post(unsigned* bar, volatile LAS unsigned* st) {
    XcdBarrier b; b.bar = bar; b.x = xb_xcc_id(); b.st = st;
    if (threadIdx.x == 0) (void)xb_add(&bar[XB_XCNT(b.x)], 1u);
    return b;
}
__device__ __forceinline__ void xcd_barrier_complete(unsigned* bar, unsigned x, unsigned& nloc, unsigned& nx) {
    const unsigned G = gridDim.x * gridDim.y * gridDim.z;
    unsigned sum, cnt, mine, sp = 0u;
    for (;;) {
        sum = 0u; cnt = 0u; mine = 0u;
#pragma unroll
        for (unsigned j = 0; j < 16; ++j) { const unsigned c = xb_ld(&bar[XB_XCNT(j)]); sum += c; cnt += (c > 0u) ? 1u : 0u; mine = (j == x) ? c : mine; }
        if (sum == G) break;
        __builtin_amdgcn_s_sleep(1);
        if ((++sp & 255u) == 0u) { if (xb_ld(&bar[XB_TMO])) break; if (sp > XB_SPIN_CAP) { atomicAdd(&bar[XB_TMO], 1u); break; } }
    }
    nloc = mine > 0u ? mine : 1u; nx = cnt > 0u ? cnt : 1u;
}
__device__ __forceinline__ void xcd_barrier(const XcdBarrier& b) {
    asm volatile("s_waitcnt vmcnt(0)" ::: "memory");
    __syncthreads();
    if (threadIdx.x == 0) {
        unsigned* bar = b.bar;
        __builtin_amdgcn_s_waitcnt(0);
        unsigned nloc = b.st[0], nx = b.st[1];
        if (nloc == 0u) { xcd_barrier_complete(bar, b.x, nloc, nx); b.st[0] = nloc; b.st[1] = nx; }
        const unsigned old = xb_add(&bar[XB_XSUB(b.x)], 1u);
        const unsigned gen = old / nloc;
        if (old + 1u == (gen + 1u) * nloc) {
            __builtin_amdgcn_fence(__ATOMIC_RELEASE, "agent");
            asm volatile("s_waitcnt vmcnt(0)" ::: "memory");
            const unsigned og = xb_add(&bar[XB_TOP], 1u);
            const unsigned tg = og / nx;
            if (og + 1u == (tg + 1u) * nx) xb_add(&bar[XB_TOPGEN], 1u);
            else XB_SPIN(xb_ld(&bar[XB_TOPGEN]) == tg, bar);
            __builtin_amdgcn_fence(__ATOMIC_ACQUIRE, "agent");
            xb_add(&bar[XB_XGEN(b.x)], 1u);
            asm volatile("s_waitcnt vmcnt(0)" ::: "memory");
        } else {
            XB_SPIN(xb_ld(&bar[XB_XGEN(b.x)]) == gen, bar);
            __builtin_amdgcn_fence(__ATOMIC_ACQUIRE, "agent");
            asm volatile("s_waitcnt vmcnt(0)" ::: "memory");
        }
    }
    __syncthreads();
}
__global__ void __launch_bounds__(512) fwd_megakernel(Params Pv) {
    extern __shared__ __attribute__((aligned(16))) unsigned char smem[];
    LAS unsigned char* lds0 = (LAS unsigned char*)smem;
    cg::grid_group grid = cg::this_grid();
    KP P0 = (KP)__builtin_amdgcn_kernarg_segment_ptr();
    volatile LAS unsigned* xst = (volatile LAS unsigned*)(lds0 + LDS_BYTES - 16);
    if (threadIdx.x == 0) { xst[0] = 0u; xst[1] = 0u; }
    __syncthreads();
    XcdBarrier xbar = xcd_barrier_post((unsigned*)(Pv.ws + WS_BAR), xst);
    const int ph_lo = Pv.ph_lo, ph_hi = Pv.ph_hi;
    const bool multi = (ph_hi - ph_lo) > 1;
    for (int ph = ph_lo; ph < ph_hi; ++ph) {
        KP P = P0; asm volatile("" : "+s"(P));
        LAS unsigned char* lds = lds0; asm volatile("" : "+s"(lds));
        int bid = blockIdx.x; asm volatile("" : "+s"(bid));
        bf16_t* xb = (bf16_t*)(P->ws + WS_XB); float* xf = (float*)(P->ws + WS_XF); float* hb = (float*)(P->ws + WS_HB); bf16_t* zb = (bf16_t*)(P->ws + WS_ZB);
        bf16_t* AB = (bf16_t*)(P->ws + WS_AB); bf16_t* mg = (bf16_t*)(P->ws + WS_MG); bf16_t* up = (bf16_t*)(P->ws + WS_UP); bf16_t* act = (bf16_t*)(P->ws + WS_ACT);

        if (ph == 0) {
            prep_weights(P, lds);
            row_phase<0>(P, 0, lds);
        } else {
            const int l = (ph - 1) / 10, s = (ph - 1) % 10;
            const bf16_t* WinT = (const bf16_t*)(P->ws + WS_WIN) + (size_t)l * ZN * DM; const bf16_t* WprT = (const bf16_t*)(P->ws + WS_WPR) + (size_t)l * DM * KPR;
            const bf16_t* WmxT = (const bf16_t*)(P->ws + WS_WMX) + (size_t)l * DM * DM; const bf16_t* WupT = (const bf16_t*)(P->ws + WS_WUP) + (size_t)l * DUP * DM;
            const bf16_t* WdnT = (const bf16_t*)(P->ws + WS_WDN) + (size_t)l * DM * DFF;
            if (s == 0) {
                pg8::Gemm g{xb, WinT, MP, ZN, DM}; pg8::StaticOrder S; S.init(MP, ZN, gridDim.x, bid);
                pg8::EpiBf16<0> E{zb, ZN, nullptr, 0, 0};
                pg8::gemm_phase<pg8::EpiBf16<0>, pg8::StaticOrder>(lds, g, S, E, nullptr);
            } else if (s == 1) {
                mlstm_pass1(P, l, lds);
                conv_branch(P, l);
                mlstm_sample(P, l, lds);
            } else if (s == 2) {
                mlstm_pass2(P, l, lds);
            } else if (s == 3) {
                {
                    pg8::Gemm g{AB, WprT, TP, DM, KPR}; pg8::StaticOrder S; S.init(TP, DM, gridDim.x, bid);
                    EpiProj E{zb, mg};
                    pg8::gemm_phase<EpiProj, pg8::StaticOrder>(lds, g, S, E, nullptr);
                }
                bar();
                { FGateA fa{zb, hb}; micro_gemm(lds, AB, KPR, WprT, KPR, 512, fa); }
                { FGateB fb{zb, hb, mg}; micro_gemm(lds, AB + 512, KPR, WprT + 512, KPR, 1024, fb); }
            } else if (s == 4) {
                FResid fr_{xf, hb};
                {
                    pg8::Gemm g{mg, WmxT, TP, DM, DM}; pg8::StaticOrder S; S.init(TP, DM, gridDim.x, bid);
                    EpiRow<FResid> E{fr_};
                    pg8::gemm_phase<EpiRow<FResid>, pg8::StaticOrder>(lds, g, S, E, nullptr);
                }
                bar();
                micro_gemm(lds, mg, DM, WmxT, DM, DM, fr_);
            } else if (s == 5) {
                row_phase<1>(P, l, lds);
            } else if (s == 6) {
                pg8::Gemm g{xb, WupT, MP, DUP, DM}; pg8::StaticOrder S; S.init(MP, DUP, gridDim.x, bid);
                EpiUp E{up, P->out + O_FP + (size_t)l * NBATCH * 2 * DUP, P->out + O_FS + (size_t)l * NSMP * 2 * DUP};
                pg8::gemm_phase<EpiUp, pg8::StaticOrder>(lds, g, S, E, nullptr);
            } else if (s == 7) {
                conv_act(P, l);
            } else if (s == 8) {
                FResid fr_{xf, hb};
                {
                    pg8::Gemm g{act, WdnT, TP, DM, DFF}; pg8::StaticOrder S; S.init(TP, DM, gridDim.x, bid);
                    EpiRow<FResid> E{fr_};
                    pg8::gemm_phase<EpiRow<FResid>, pg8::StaticOrder>(lds, g, S, E, nullptr);
                }
                bar();
                micro_gemm(lds, act, DFF, WdnT, DFF, DFF, fr_);
            } else {
                if (l + 1 < DEPTH) row_phase<2>(P, l, lds); else row_phase<3>(P, l, lds);
            }
        }
        if (multi && ph + 1 < ph_hi) { if (ph == ph_lo) grid.sync(); else xcd_barrier(xbar); }
    }
}

extern "C" void kernel_launch(void* const* d_in, const int* in_sizes, int n_in, void* d_out, int out_size, void* d_ws, size_t ws_size, hipStream_t stream) {
    static int grid_blocks = 0;
    if (grid_blocks == 0) {
        int dev = 0, cus = 0, per_cu = 0;
        hipGetDevice(&dev);
        hipDeviceGetAttribute(&cus, hipDeviceAttributeMultiprocessorCount, dev);
        if (hipFuncSetAttribute((const void*)fwd_megakernel, hipFuncAttributeMaxDynamicSharedMemorySize, LDS_BYTES) != hipSuccess) fprintf(stderr, "hipFuncSetAttribute failed\n");
        hipOccupancyMaxActiveBlocksPerMultiprocessor(&per_cu, (const void*)fwd_megakernel, 512, LDS_BYTES);
        if (per_cu < 1) { fprintf(stderr, "occupancy query says %d blocks/CU\n", per_cu); per_cu = 1; }
        grid_blocks = cus * 1;
        (void)hipGetLastError();
        if (ws_size < WS_END) fprintf(stderr, "workspace too small: %zu < %zu\n", ws_size, (size_t)WS_END);
    }
    (void)hipMemsetAsync((char*)d_ws + WS_BAR, 0, XCD_BAR_WORDS_C * 4, stream);
    Params p{};
    for (int i = 0; i < 22; ++i) p.in[i] = (const float*)d_in[i];
    p.out = (float*)d_out; p.ws = (unsigned char*)d_ws; p.ph_lo = 0; p.ph_hi = 1 + 10 * DEPTH;
    void* args[] = {&p};
    hipError_t e = hipLaunchCooperativeKernel((const void*)fwd_megakernel, dim3(grid_blocks), dim3(512), args, LDS_BYTES, stream);
    if (e != hipSuccess) fprintf(stderr, "cooperative launch failed: %s (grid %d)\n", hipGetErrorString(e), grid_blocks);
}
```
